# Optimizing an MI355X kernel written in HIP

```python
import functools
import jax, jax.numpy as jnp
from jax import lax
import numpy as np

D_MODEL = 1024
BATCH = 4
SEQ = 8192
DEPTH = 4
DEC_BATCH = 32
DEC_SEQ = 16
PAST_LEN = 1024

CHUNK = 64
N_MIXERS = 2
N_FOX = (DEPTH + 1) // 2
N_POOL = DEPTH // 2
N_HEADS = 16
HEAD_DIM = D_MODEL // N_HEADS
ATTN_SCALE = HEAD_DIM ** -0.5
Q_BLOCK = 128
D_FF = 2816
PLE_DIM = 256
POOL_WINDOWS = (2, 4, 8, 16)
N_POOL_GROUPS = len(POOL_WINDOWS)
POOL_GROUP = D_MODEL // N_POOL_GROUPS
POOL_STATE = max(POOL_WINDOWS) - 1
ALPHA = (2.0 * DEPTH) ** 0.25
BETA = (8.0 * DEPTH) ** -0.25
LN_EPS = 1e-5

kernel_name = "fox_pool_macaron_deepnorm_stream_step"


def _layer_norm(x, g, b):
    xf = x.astype(jnp.float32)
    mu = jnp.mean(xf, axis=-1, keepdims=True)
    var = jnp.mean(jnp.square(xf - mu), axis=-1, keepdims=True)
    return ((xf - mu) * lax.rsqrt(var + LN_EPS) * g + b).astype(x.dtype)


def _post_norm(x, sub, g, b):
    return _layer_norm(ALPHA * x + sub, g, b)


def _swiglu(x, w_in, w_out):
    h = x @ w_in
    a, u = h[..., :D_FF], h[..., D_FF:]
    return (jax.nn.silu(a) * u) @ w_out


def _fox_project(x, w_in, b_f):
    B, T, _ = x.shape
    h = x @ w_in
    qkv = h[..., :3 * D_MODEL].reshape(B, T, 3, N_HEADS, HEAD_DIM)
    logf = jax.nn.log_sigmoid((h[..., 3 * D_MODEL:] + b_f).astype(jnp.float32))
    return qkv[:, :, 0], qkv[:, :, 1], qkv[:, :, 2], logf


def _fox_attend(q, f_q, pos_q, k, v, f_k, pos_k):
    s = jnp.einsum("bqhd,bkhd->bhqk", q, k).astype(jnp.float32) * ATTN_SCALE
    s = s + (f_q[..., :, None] - f_k[..., None, :])
    s = jnp.where(pos_k[None, :] <= pos_q[:, None], s, -jnp.inf)
    w = jax.nn.softmax(s, axis=-1).astype(v.dtype)
    return jnp.einsum("bhqk,bkhd->bqhd", w, v)


def _fox_prompt(x, w_in, b_f, w_o):
    B, S, _ = x.shape
    q, k, v, logf = _fox_project(x, w_in, b_f)
    F = jnp.cumsum(logf, axis=1).transpose(0, 2, 1)
    pos = jnp.arange(S)
    nb = S // Q_BLOCK
    q_blocks = q.reshape(B, nb, Q_BLOCK, N_HEADS, HEAD_DIM).transpose(1, 0, 2, 3, 4)
    f_blocks = F.reshape(B, N_HEADS, nb, Q_BLOCK).transpose(2, 0, 1, 3)
    p_blocks = pos.reshape(nb, Q_BLOCK)

    def one_block(args):
        qb, fb, pb = args
        return _fox_attend(qb, fb, pb, k, v, F, pos)

    o = lax.map(one_block, (q_blocks, f_blocks, p_blocks))
    o = o.transpose(1, 0, 2, 3, 4).reshape(B, S, D_MODEL)
    return o @ w_o, (k, v, logf)


def _fox_sample(x, cache_k, cache_v, cache_logf, w_in, b_f, w_o):
    B, T, _ = x.shape
    P = cache_k.shape[1]
    q, k, v, logf = _fox_project(x, w_in, b_f)
    logf_all = jnp.concatenate([cache_logf.astype(jnp.float32), logf], axis=1)
    F = jnp.cumsum(logf_all, axis=1).transpose(0, 2, 1)
    k_all = jnp.concatenate([cache_k, k.astype(cache_k.dtype)], axis=1)
    v_all = jnp.concatenate([cache_v, v.astype(cache_v.dtype)], axis=1)
    pos = jnp.arange(P + T)
    o = _fox_attend(q, F[:, :, P:], pos[P:], k_all, v_all, F, pos)
    return o.reshape(B, T, D_MODEL) @ w_o, (k, v, logf)


def _pool_mix(x_ext, n_hist, w_pool, scale):
    B, L, _ = x_ext.shape
    T = L - n_hist
    xf = x_ext.astype(jnp.float32)
    cs = jnp.concatenate([jnp.zeros((B, 1, D_MODEL), jnp.float32), jnp.cumsum(xf, axis=1)], axis=1)
    t = jnp.arange(n_hist, L)
    hi = cs[:, n_hist + 1:]
    groups = []
    for g, w in enumerate(POOL_WINDOWS):
        sl = slice(g * POOL_GROUP, (g + 1) * POOL_GROUP)
        lo_idx = jnp.maximum(t + 1 - w, 0)
        lo = jnp.take(cs[..., sl], lo_idx, axis=1)
        cnt = (t + 1 - lo_idx).astype(jnp.float32)
        groups.append((hi[..., sl] - lo) / cnt[None, :, None])
    pooled = jnp.concatenate(groups, axis=-1) - xf[:, n_hist:]
    pooled = pooled.reshape(B, T, N_POOL_GROUPS, POOL_GROUP).astype(x_ext.dtype)
    y = jnp.einsum("btgc,gcd->btgd", pooled, w_pool).reshape(B, T, D_MODEL)
    return y * scale


def _pool_prompt(x, w_pool, scale):
    return _pool_mix(x, 0, w_pool, scale), (x[:, -POOL_STATE:],)


def _pool_sample(x, state, w_pool, scale):
    ext = jnp.concatenate([state, x.astype(state.dtype)], axis=1)
    return _pool_mix(ext, POOL_STATE, w_pool, scale), (ext[:, -POOL_STATE:],)


def _layer(x, p_i, i, mixer, ln_g, ln_b, ffn_w_in, ffn_w_out, ple_w_proj, ple_w_gate, ple_b_gate):
    x = _post_norm(x, 0.5 * _swiglu(x, ffn_w_in[i, 0], ffn_w_out[i, 0]), ln_g[i, 0], ln_b[i, 0])
    m, state = mixer(x)
    x = _post_norm(x, m, ln_g[i, 1], ln_b[i, 1])
    x = _post_norm(x, 0.5 * _swiglu(x, ffn_w_in[i, 1], ffn_w_out[i, 1]), ln_g[i, 2], ln_b[i, 2])
    gate = jax.nn.sigmoid(x @ ple_w_gate[i] + ple_b_gate[i])
    x = _post_norm(x, (p_i @ ple_w_proj[i]) * gate, ln_g[i, 3], ln_b[i, 3])
    return x, state


def setup_inputs(seed: int = 0) -> dict:
    key = jax.random.key(seed)
    ks = jax.random.split(key, 24)
    f32 = jnp.float32
    nrm = lambda k, shape, s: jax.random.normal(k, shape, f32) * s
    b_f_base = jnp.linspace(1.0, 5.0, N_HEADS, dtype=f32)
    return {
        "x_prompt": nrm(ks[0], (BATCH, SEQ, D_MODEL), 1.0),
        "x_sample": nrm(ks[1], (DEC_BATCH, DEC_SEQ, D_MODEL), 1.0),
        "cache_fox_k": nrm(ks[2], (N_FOX, DEC_BATCH, PAST_LEN, N_HEADS, HEAD_DIM), 1.0),
        "cache_fox_v": nrm(ks[3], (N_FOX, DEC_BATCH, PAST_LEN, N_HEADS, HEAD_DIM), 1.0),
        "cache_fox_logf": jax.nn.log_sigmoid(3.0 + nrm(ks[4], (N_FOX, DEC_BATCH, PAST_LEN, N_HEADS), 1.0)),
        "state_pool": nrm(ks[5], (N_POOL, DEC_BATCH, POOL_STATE, D_MODEL), 1.0),
        "p_prompt": nrm(ks[6], (DEPTH, BATCH, SEQ, PLE_DIM), 1.0),
        "p_sample": nrm(ks[7], (DEPTH, DEC_BATCH, DEC_SEQ, PLE_DIM), 1.0),
        "ln_g": 1.0 + nrm(ks[8], (DEPTH, 4, D_MODEL), 0.02),
        "ln_b": nrm(ks[9], (DEPTH, 4, D_MODEL), 0.02),
        "ffn_w_in": nrm(ks[10], (DEPTH, 2, D_MODEL, 2 * D_FF), D_MODEL ** -0.5),
        "ffn_w_out": nrm(ks[11], (DEPTH, 2, D_FF, D_MODEL), BETA * D_FF ** -0.5),
        "fox_w_in": jnp.concatenate([
            nrm(ks[12], (N_FOX, D_MODEL, 3 * D_MODEL), D_MODEL ** -0.5),
            nrm(ks[13], (N_FOX, D_MODEL, N_HEADS), 0.5 * D_MODEL ** -0.5)], axis=-1),
        "fox_b_f": b_f_base[None, :] + nrm(ks[14], (N_FOX, N_HEADS), 0.1),
        "fox_w_o": nrm(ks[15], (N_FOX, D_MODEL, D_MODEL), BETA * D_MODEL ** -0.5),
        "pool_w": nrm(ks[16], (N_POOL, N_POOL_GROUPS, POOL_GROUP, POOL_GROUP), BETA * POOL_GROUP ** -0.5),
        "pool_scale": 1.0 + nrm(ks[17], (N_POOL, D_MODEL), 0.02),
        "ple_w_proj": nrm(ks[18], (DEPTH, PLE_DIM, D_MODEL), BETA * PLE_DIM ** -0.5),
        "ple_w_gate": nrm(ks[19], (DEPTH, D_MODEL, D_MODEL), D_MODEL ** -0.5),
        "ple_b_gate": nrm(ks[20], (DEPTH, D_MODEL), 0.02),
    }


def reference(x_prompt, x_sample, cache_fox_k, cache_fox_v, cache_fox_logf, state_pool,
              p_prompt, p_sample, ln_g, ln_b, ffn_w_in, ffn_w_out, fox_w_in, fox_b_f, fox_w_o,
              pool_w, pool_scale, ple_w_proj, ple_w_gate, ple_b_gate):
    shared = dict(ln_g=ln_g, ln_b=ln_b, ffn_w_in=ffn_w_in, ffn_w_out=ffn_w_out,
                  ple_w_proj=ple_w_proj, ple_w_gate=ple_w_gate, ple_b_gate=ple_b_gate)
    yp, ys = x_prompt, x_sample
    kp, vp, fp, poolp = [], [], [], []
    ksm, vsm, fsm, pools = [], [], [], []
    for i in range(DEPTH):
        j = i // N_MIXERS
        if i % N_MIXERS == 0:
            mix_p = functools.partial(_fox_prompt, w_in=fox_w_in[j], b_f=fox_b_f[j], w_o=fox_w_o[j])
            mix_s = functools.partial(_fox_sample, cache_k=cache_fox_k[j], cache_v=cache_fox_v[j],
                                      cache_logf=cache_fox_logf[j], w_in=fox_w_in[j],
                                      b_f=fox_b_f[j], w_o=fox_w_o[j])
            yp, (k1, v1, f1) = _layer(yp, p_prompt[i], i, mix_p, **shared)
            ys, (k2, v2, f2) = _layer(ys, p_sample[i], i, mix_s, **shared)
            kp.append(k1); vp.append(v1); fp.append(f1)
            ksm.append(k2); vsm.append(v2); fsm.append(f2)
        else:
            mix_p = functools.partial(_pool_prompt, w_pool=pool_w[j], scale=pool_scale[j])
            mix_s = functools.partial(_pool_sample, state=state_pool[j], w_pool=pool_w[j], scale=pool_scale[j])
            yp, (s1,) = _layer(yp, p_prompt[i], i, mix_p, **shared)
            ys, (s2,) = _layer(ys, p_sample[i], i, mix_s, **shared)
            poolp.append(s1); pools.append(s2)
    return (yp, ys, jnp.stack(kp), jnp.stack(vp), jnp.stack(fp), jnp.stack(poolp),
            jnp.stack(ksm), jnp.stack(vsm), jnp.stack(fsm), jnp.stack(pools))
```

```cpp
#include <hip/hip_runtime.h>
#include <hip/hip_bf16.h>
#include <cstdio>
#include <cstdint>
#include <cmath>

constexpr int D = 1024, NB = 4, SEQ = 8192, DEPTH = 4, DECB = 32, DECS = 16, PAST = 1024, NH = 16, HD = 64, DFF = 2816, PLE = 256;
constexpr int MP = NB * SEQ;
constexpr int MS = DECB * DECS;
constexpr int M = MP + MS;
constexpr float LN_EPS = 1e-5f;
constexpr float ALPHA = 1.6817928305074292f;
constexpr float LOG2E = 1.4426950408889634f;
constexpr float C2 = 0.125f * 1.4426950408889634f;

__device__ __forceinline__ float xadd16(float x) { auto r = __builtin_amdgcn_permlane16_swap(__float_as_uint(x), __float_as_uint(x), false, false); return __uint_as_float(r[0]) + __uint_as_float(r[1]); }
__device__ __forceinline__ float xadd32(float x) { auto r = __builtin_amdgcn_permlane32_swap(__float_as_uint(x), __float_as_uint(x), false, false); return __uint_as_float(r[0]) + __uint_as_float(r[1]); }
__device__ __forceinline__ float xmax16(float x) { auto r = __builtin_amdgcn_permlane16_swap(__float_as_uint(x), __float_as_uint(x), false, false); return fmaxf(__uint_as_float(r[0]), __uint_as_float(r[1])); }
__device__ __forceinline__ float xmax32(float x) { auto r = __builtin_amdgcn_permlane32_swap(__float_as_uint(x), __float_as_uint(x), false, false); return fmaxf(__uint_as_float(r[0]), __uint_as_float(r[1])); }
__device__ __forceinline__ float bperm(float v, int src_lane) { return __uint_as_float((unsigned)__builtin_amdgcn_ds_bpermute(src_lane << 2, (int)__float_as_uint(v))); }

typedef _Float16 h16x2 __attribute__((ext_vector_type(2)));
typedef _Float16 h16x8 __attribute__((ext_vector_type(8)));
#ifndef Z_MODE
#define Z_MODE 1
#endif
constexpr bool ZBF_E = (Z_MODE >= 1), ZBF_O = (Z_MODE >= 2);
typedef float f32x2g __attribute__((ext_vector_type(2)));
typedef __bf16 b16x2g __attribute__((ext_vector_type(2)));
template <bool BF> __device__ __forceinline__ unsigned pkz(float lo, float hi) { const f32x2g v = {lo, hi}; if (BF) return __builtin_bit_cast(unsigned, __builtin_convertvector(v, b16x2g)); else return __builtin_bit_cast(unsigned, __builtin_convertvector(v, h16x2)); }
template <bool BF> __device__ __forceinline__ f32x2g upz(unsigned w) { if (BF) return (f32x2g){__uint_as_float(w << 16), __uint_as_float(w & 0xffff0000u)}; else return __builtin_convertvector(__builtin_bit_cast(h16x2, w), f32x2g); }

namespace pg8 {
#define PG8_LAS __attribute__((address_space(3)))
typedef unsigned short bf16_t;
typedef short bf16x8 __attribute__((ext_vector_type(8)));
typedef float f32x4 __attribute__((ext_vector_type(4)));
typedef float f32x2 __attribute__((ext_vector_type(2)));
typedef unsigned u32x4 __attribute__((ext_vector_type(4)));
constexpr int BM = 256, BK = 64, HALF = 128, HTB = HALF * BK * 2, STAGE_BYTES = 8 * HTB, NXCD = 8, WGM = 8;

__host__ __device__ __forceinline__ int lds_byte(int r, int c) { const int st = (r >> 4) * 2 + (c >> 5), rr = r & 15, cc = c & 31, ob = rr * 64 + cc * 2; return st * 1024 + (ob ^ (((ob >> 9) & 1) << 5)); }
__host__ __device__ __forceinline__ void stage_rc(int b, int& R, int& C) { const int st = b / 1024, sb = b % 1024, swz = sb ^ (((sb >> 9) & 1) << 5); R = (st >> 1) * 16 + swz / 64; C = (st & 1) * 32 + (swz % 64) / 2; }
__host__ __device__ __forceinline__ int perm32(int rho) { const int n = rho >> 4, i = rho & 15; return 8 * (i >> 2) + 4 * n + (i & 3); }

struct Unit { int pm, pn, slot; };
struct Gemm { const bf16_t* A; const bf16_t* Bt; int M, N, K, lda, apn; };

struct StaticOrder {
    int nM, nN, nwg, G, c;
    __host__ __device__ void init(int M_, int N_, int G_, int c_) { nM = M_ / BM; nN = N_ / BM; nwg = nM * nN; G = G_; c = c_; }
    __host__ __device__ bool next(int i, Unit& u) const {
        const long L = (long)i * G + c; if (L >= nwg) return false;
        int wgid = (int)L; { const int q = nwg / NXCD, r = nwg % NXCD, xcd = wgid % NXCD, off = wgid / NXCD; wgid = (xcd < r ? xcd * (q + 1) : r * (q + 1) + (xcd - r) * q) + off; }
        const int nig = WGM * nN, gid = wgid / nig, fm = gid * WGM, gsz = (nM - fm) < WGM ? (nM - fm) : WGM;
        u.pm = fm + ((wgid % nig) % gsz); u.pn = (wgid % nig) / gsz; return true;
    }
    __device__ __forceinline__ void a_ready(const Unit&) const {}
    __device__ __forceinline__ void done(const Unit&) const {}
    __device__ __forceinline__ int first_same_pm(int ui, int pm) const { Unit t; for (int k = 0; k < ui; ++k) { next(k, t); if (t.pm == pm) return k; } return ui; }
};

typedef __bf16 bf16x2n __attribute__((ext_vector_type(2)));
__device__ __forceinline__ unsigned cvt_pk_bf16(float lo, float hi) { const f32x2 v = {lo, hi}; return __builtin_bit_cast(unsigned, __builtin_convertvector(v, bf16x2n)); }
__device__ __forceinline__ u32x4 pack8(const f32x4 a, const f32x4 b) { u32x4 w; w.x = cvt_pk_bf16(a[0], a[1]); w.y = cvt_pk_bf16(a[2], a[3]); w.z = cvt_pk_bf16(b[0], b[1]); w.w = cvt_pk_bf16(b[2], b[3]); return w; }
__device__ __forceinline__ f32x4 bf_lo4(const u32x4 w) { f32x4 r; r[0] = __uint_as_float(w.x << 16); r[1] = __uint_as_float(w.x & 0xffff0000u); r[2] = __uint_as_float(w.y << 16); r[3] = __uint_as_float(w.y & 0xffff0000u); return r; }
__device__ __forceinline__ f32x4 bf_hi4(const u32x4 w) { f32x4 r; r[0] = __uint_as_float(w.z << 16); r[1] = __uint_as_float(w.z & 0xffff0000u); r[2] = __uint_as_float(w.w << 16); r[3] = __uint_as_float(w.w & 0xffff0000u); return r; }

typedef PG8_LAS const f32x2* StatTab;

#ifndef EPI_PRE_SWIGLU
#define EPI_PRE_SWIGLU 1
#endif
struct EpiSwiglu {
    static constexpr bool PERM = true, AFTER_DRAIN = false;
    bf16_t* H; StatTab T; const float* gW; const float* bW; int dry;
    static constexpr bool HAS_PRE = EPI_PRE_SWIGLU;
    PG8_LAS float* V;
    __device__ __forceinline__ float prefetch(const Unit& u, int tid) const { return ((tid & 256) ? bW : gW)[u.pn * BM + (tid & 255)]; }
    __device__ __forceinline__ void commit(float v, int ui, int tid) const { V[(ui & 1) * 512 + tid] = v; }
    __device__ __forceinline__ void operator()(const f32x4 (&acc)[2][2][4][2], const Unit& u, int wr, int wc, int fr, int fq, int ui = 0) const {
        if (dry) return;
        const int hc0 = wc * 32 + 8 * fq, nrow = u.pn * BM + hc0;
        f32x2 ga[4], ba[4], gu[4], bu[4];
        if constexpr (HAS_PRE) { const PG8_LAS float* v = V + (ui & 1) * 512 + hc0;
#pragma unroll
            for (int p = 0; p < 4; ++p) { ga[p] = *(const PG8_LAS f32x2*)(v + 2 * p); ba[p] = *(const PG8_LAS f32x2*)(v + 256 + 2 * p); gu[p] = *(const PG8_LAS f32x2*)(v + 128 + 2 * p); bu[p] = *(const PG8_LAS f32x2*)(v + 384 + 2 * p); }
        } else {
#pragma unroll
        for (int p = 0; p < 4; ++p) { ga[p] = *(const f32x2*)(gW + nrow + 2 * p); ba[p] = *(const f32x2*)(bW + nrow + 2 * p); gu[p] = *(const f32x2*)(gW + nrow + 128 + 2 * p); bu[p] = *(const f32x2*)(bW + nrow + 128 + 2 * p); }
        }
#pragma unroll
        for (int ai = 0; ai < 2; ++ai)
#pragma unroll
            for (int m = 0; m < 4; ++m) {
                const int lrow = ai * HALF + wr * 64 + m * 16 + fr, row = u.pm * BM + lrow;
                const f32x2 mr_ = T[u.slot * BM + lrow]; const float rs = mr_[1], nmr = -mr_[0] * rs;
                f32x2 A[4], U[4], d[4];
#pragma unroll
                for (int p = 0; p < 4; ++p) {
                    const f32x4 ra = acc[ai][0][m][p >> 1], ru = acc[ai][1][m][p >> 1];
                    const f32x2 xa = (p & 1) ? (f32x2){ra[2], ra[3]} : (f32x2){ra[0], ra[1]}, xu = (p & 1) ? (f32x2){ru[2], ru[3]} : (f32x2){ru[0], ru[1]};
                    A[p] = xa * rs + (ga[p] * nmr + ba[p]); U[p] = xu * rs + (gu[p] * nmr + bu[p]); }
#pragma unroll
                for (int p = 0; p < 4; ++p) d[p] = A[p] * (-LOG2E);
#pragma unroll
                for (int p = 0; p < 4; ++p) { d[p].x = __builtin_amdgcn_exp2f(d[p].x); d[p].y = __builtin_amdgcn_exp2f(d[p].y); }
#pragma unroll
                for (int p = 0; p < 4; ++p) { d[p] = d[p] + 1.0f; U[p] = U[p] * A[p]; }
#pragma unroll
                for (int p = 0; p < 4; ++p) { d[p].x = __builtin_amdgcn_rcpf(d[p].x); d[p].y = __builtin_amdgcn_rcpf(d[p].y); }
                unsigned w[4];
#pragma unroll
                for (int p = 0; p < 4; ++p) { const f32x2 h = U[p] * d[p]; w[p] = cvt_pk_bf16(h.x, h.y); }
                __builtin_nontemporal_store((u32x4){w[0], w[1], w[2], w[3]}, (u32x4*)(H + ((unsigned)row * DFF + u.pn * HALF + hc0)));
            }
    }
};

struct EpiQKV {
    static constexpr bool PERM = true, AFTER_DRAIN = false;
    static constexpr bool HAS_PRE = false;
    bf16_t* Q; float *kp, *ks; StatTab T; const float* gW; const float* bW;
    __device__ __forceinline__ void operator()(const f32x4 (&acc)[2][2][4][2], const Unit& u, int wr, int wc, int fr, int fq) const {
        const int colt = u.pn * BM, t = colt >> 10, nrow = colt + wc * 32 + 8 * fq, cb = (colt & 1023) + wc * 32 + 8 * fq;
        f32x4 g[2][2], b[2][2];
#pragma unroll
        for (int bj = 0; bj < 2; ++bj)
#pragma unroll
            for (int n = 0; n < 2; ++n) { g[bj][n] = *(const f32x4*)(gW + nrow + bj * HALF + 4 * n); b[bj][n] = *(const f32x4*)(bW + nrow + bj * HALF + 4 * n); }
        bf16_t* ob = Q + (size_t)t * ((size_t)M * D);
        const bool samp = (u.pm >= MP / BM);
        float* of = (samp ? ks : kp) + (t == 2 ? (samp ? 2ull * MS * D : 2ull * MP * D) : 0ull);
        const float sc = (t == 0) ? C2 : 1.0f;
#pragma unroll
        for (int ai = 0; ai < 2; ++ai)
#pragma unroll
            for (int m = 0; m < 4; ++m) {
                const int lrow = ai * HALF + wr * 64 + m * 16 + fr, row = u.pm * BM + lrow;
                const f32x2 mr_ = T[u.slot * BM + lrow]; const float rs = mr_[1], mr = mr_[0] * rs;
                const int orow = samp ? row - MP : row;
#pragma unroll
                for (int bj = 0; bj < 2; ++bj) {
                    const f32x4 v0 = acc[ai][bj][m][0] * rs + (b[bj][0] - mr * g[bj][0]), v1 = acc[ai][bj][m][1] * rs + (b[bj][1] - mr * g[bj][1]);
                    *(u32x4*)(ob + ((unsigned)row * D + cb + bj * HALF)) = pack8(v0 * sc, v1 * sc);
                    if (t != 0) { float* o = of + ((unsigned)orow * D + cb + bj * HALF); __builtin_nontemporal_store(v0, (f32x4*)o); __builtin_nontemporal_store(v1, (f32x4*)(o + 4)); }
                }
            }
    }
};

struct EpiStoreBf16 {
    static constexpr bool PERM = true, AFTER_DRAIN = false;
    static constexpr bool HAS_PRE = false;
    bf16_t* O;
    __device__ __forceinline__ void operator()(const f32x4 (&acc)[2][2][4][2], const Unit& u, int wr, int wc, int fr, int fq) const {
        const int col = u.pn * BM + wc * 32 + 8 * fq;
#pragma unroll
        for (int ai = 0; ai < 2; ++ai)
#pragma unroll
            for (int m = 0; m < 4; ++m) {
                const int row = u.pm * BM + ai * HALF + wr * 64 + m * 16 + fr;
#pragma unroll
                for (int bj = 0; bj < 2; ++bj) *(u32x4*)(O + ((unsigned)row * D + col + bj * HALF)) = pack8(acc[ai][bj][m][0], acc[ai][bj][m][1]);
            }
    }
};

template <int MODE, bool INBF, bool OUTBF> struct EpiRes {
    static constexpr bool PERM = true, AFTER_DRAIN = false;
    static constexpr bool HAS_PRE = false;
    const bf16_t* zp; bf16_t* zb; float* st_out; StatTab T; const float* gp; const float* bp;
    float cs; const float* vec; const float* gW; const float* cW; const bf16_t* pp; int dry;
    static constexpr int GS = (MODE == 2) ? 2 : 4;
    static __device__ __forceinline__ unsigned loff(int L) { return (unsigned)((L >> 3) * HALF + ((L >> 2) & 1) * HALF * D + (L & 3) * 16 * D); }
    __device__ __forceinline__ void operator()(const f32x4 (&acc)[2][2][4][2], const Unit& u, int wr, int wc, int fr, int fq) const {
        if (dry) return;
        const int lrow0 = wr * 64 + fr;
        const unsigned offb = (unsigned)(u.pm * BM + lrow0) * D + u.pn * BM + wc * 32 + 8 * fq;
        u32x4 zbuf[2][GS], pbuf[2][GS];
#pragma unroll
        for (int k = 0; k < GS; ++k) { zbuf[0][k] = *(const u32x4*)(zp + offb + loff(k)); if (MODE == 2) pbuf[0][k] = *(const u32x4*)(pp + offb + loff(k)); }
        f32x2 gA[4], bA[4], e_[4], f_[4];
#pragma unroll
        for (int st = 0; st < 16 / GS; ++st) {
            if (st + 1 < 16 / GS) {
#pragma unroll
                for (int k = 0; k < GS; ++k) { const unsigned o = offb + loff((st + 1) * GS + k); zbuf[(st + 1) & 1][k] = *(const u32x4*)(zp + o); if (MODE == 2) pbuf[(st + 1) & 1][k] = *(const u32x4*)(pp + o); }
            }
#pragma unroll
            for (int k = 0; k < GS; ++k) {
                const int L = st * GS + k, bj = L >> 3, ai = (L >> 2) & 1, m = L & 3;
                const int col = u.pn * BM + bj * HALF + wc * 32 + 8 * fq;
                if ((L & 7) == 0) {
#pragma unroll
                    for (int p = 0; p < 4; ++p) { gA[p] = *(const f32x2*)(gp + col + 2 * p) * ALPHA; bA[p] = *(const f32x2*)(bp + col + 2 * p) * ALPHA;
                        if (MODE == 1) e_[p] = *(const f32x2*)(vec + col + 2 * p);
                        if (MODE == 2) { e_[p] = *(const f32x2*)(gW + col + 2 * p); f_[p] = *(const f32x2*)(cW + col + 2 * p); } }
                }
                const int lrow = lrow0 + ai * HALF + m * 16, row = u.pm * BM + lrow; const unsigned off = (unsigned)row * D + col;
                const u32x4 zw = zbuf[st & 1][k], pw = pbuf[st & 1][k];
                const f32x2 mr_ = T[u.slot * BM + lrow]; const float r_ = mr_[1], nmr = -mr_[0] * r_;
                unsigned w[4]; f32x2 s2 = {0.f, 0.f}, q2 = {0.f, 0.f}, z[4], xa[4], d[4];
#pragma unroll
                for (int p = 0; p < 4; ++p) { const f32x4 ra = acc[ai][bj][m][p >> 1]; xa[p] = (p & 1) ? (f32x2){ra[2], ra[3]} : (f32x2){ra[0], ra[1]}; z[p] = upz<INBF>(zw[p]) * r_ + nmr; }
#pragma unroll
                for (int p = 0; p < 4; ++p) { z[p] = z[p] * gA[p] + bA[p]; if (MODE == 2) d[p] = (xa[p] * r_ + (e_[p] * nmr + f_[p])) * (-LOG2E); }
                if (MODE == 2) {
#pragma unroll
                    for (int p = 0; p < 4; ++p) { d[p].x = __builtin_amdgcn_exp2f(d[p].x); d[p].y = __builtin_amdgcn_exp2f(d[p].y); }
#pragma unroll
                    for (int p = 0; p < 4; ++p) d[p] = d[p] + 1.0f;
#pragma unroll
                    for (int p = 0; p < 4; ++p) { d[p].x = __builtin_amdgcn_rcpf(d[p].x); d[p].y = __builtin_amdgcn_rcpf(d[p].y); }
                }
#pragma unroll
                for (int p = 0; p < 4; ++p) {
                    if (MODE == 0) z[p] = xa[p] * cs + z[p];
                    else if (MODE == 1) z[p] = xa[p] * e_[p] + z[p];
                    else { const f32x2 pf = {__uint_as_float(pw[p] << 16), __uint_as_float(pw[p] & 0xffff0000u)}; z[p] = pf * d[p] + z[p]; }
                }
#pragma unroll
                for (int p = 0; p < 4; ++p) { w[p] = pkz<OUTBF>(z[p].x, z[p].y); s2 += z[p]; q2 = z[p] * z[p] + q2; }
                *(u32x4*)(zb + off) = (u32x4){w[0], w[1], w[2], w[3]};
                float s = s2.x + s2.y, q = q2.x + q2.y;
                s = xadd32(xadd16(s)); q = xadd32(xadd16(q));
                if (fq == 0) *(f32x2*)(st_out + (unsigned)row * 64 + (u.pn * 8 + bj * 4 + wc) * 2) = (f32x2){s, q};
            }
            asm volatile("" ::: "memory");
        }
    }
};

struct NoHook { static constexpr bool REAL = false; __device__ __forceinline__ void operator()() const {} };
template <class Epi, class Sched, bool ALIGN_EPI = false, bool SP2 = false, bool F16 = false, bool PEEL = false, class Hook = NoHook>
__device__ __forceinline__ void gemm_phase(PG8_LAS unsigned char* lds, const Gemm g, const Sched& S, const Epi& E, const int tid, const Hook& hook = Hook()) {
    const int wid = __builtin_amdgcn_readfirstlane(tid >> 6), lane = tid & 63, wr = wid >> 2, wc = wid & 3, fr = lane & 15, fq = lane >> 4;
    const int K = g.K, nt = K / BK;
    unsigned voffA[2], voffB[2];
#pragma unroll
    for (int i = 0; i < 2; ++i) { int R, C; stage_rc(tid * 16 + i * 8192, R, C); const int Rb = Epi::PERM ? ((R & ~31) + perm32(R & 31)) : R;
        voffA[i] = (unsigned)(R * g.lda + C) * 2u; voffB[i] = (unsigned)(Rb * K + C) * 2u; }
    const size_t kstep = (size_t)(BK * 2);
    const size_t hstepA = (size_t)HALF * g.lda * 2, hstepB = (size_t)HALF * K * 2;
    const size_t tstepA = 2 * hstepA, tstepB = 2 * hstepB;
    const unsigned ldsw = (unsigned)wid * 1024u;
    const int aoff = lds_byte(wr * 64 + fr, fq * 8), boff = lds_byte(wc * 32 + fr, fq * 8);
#define PG8_SA(b, h) (((b) * 2 + (h)) * HTB)
#define PG8_SB(b, h) ((4 + (b) * 2 + (h)) * HTB)
#define PG8_STAGE(bufoff, gbase, voff) do { _Pragma("unroll") for (int _i = 0; _i < 2; ++_i) \
        __builtin_amdgcn_global_load_lds((const unsigned*)((const char*)(gbase) + (voff)[_i]), (PG8_LAS unsigned*)(lds + (bufoff) + ldsw + _i * 8192), 16, 0, 0); } while (0)
#define PG8_LDA(dst, b, h) do { _Pragma("unroll") for (int m = 0; m < 4; ++m) _Pragma("unroll") for (int k = 0; k < 2; ++k) dst[m][k] = *(const PG8_LAS bf16x8*)(lds + PG8_SA(b, h) + aoff + m * 2048 + k * 1024); } while (0)
#define PG8_LDB(dst, b, h) do { _Pragma("unroll") for (int n = 0; n < 2; ++n) _Pragma("unroll") for (int k = 0; k < 2; ++k) dst[n][k] = *(const PG8_LAS bf16x8*)(lds + PG8_SB(b, h) + boff + n * 2048 + k * 1024); } while (0)
#define PG8_MMA(ai, bj, At, Bt) do { __builtin_amdgcn_s_setprio(1); _Pragma("unroll") for (int m = 0; m < 4; ++m) _Pragma("unroll") for (int n = 0; n < 2; ++n) _Pragma("unroll") for (int k = 0; k < 2; ++k) \
        acc[ai][bj][m][n] = F16 ? __builtin_amdgcn_mfma_f32_16x16x32_f16(__builtin_bit_cast(h16x8, Bt[n][k]), __builtin_bit_cast(h16x8, At[m][k]), acc[ai][bj][m][n], 0, 0, 0) \
                                : __builtin_amdgcn_mfma_f32_16x16x32_bf16(Bt[n][k], At[m][k], acc[ai][bj][m][n], 0, 0, 0); __builtin_amdgcn_s_setprio(0); } while (0)
#define PG8_MMA0(ai, bj, At, Bt) do { __builtin_amdgcn_s_setprio(1); _Pragma("unroll") for (int m = 0; m < 4; ++m) _Pragma("unroll") for (int n = 0; n < 2; ++n) { \
        acc[ai][bj][m][n] = F16 ? __builtin_amdgcn_mfma_f32_16x16x32_f16(__builtin_bit_cast(h16x8, Bt[n][0]), __builtin_bit_cast(h16x8, At[m][0]), (f32x4){0.f, 0.f, 0.f, 0.f}, 0, 0, 0) \
                                : __builtin_amdgcn_mfma_f32_16x16x32_bf16(Bt[n][0], At[m][0], (f32x4){0.f, 0.f, 0.f, 0.f}, 0, 0, 0); \
        asm("" : "+v"(acc[ai][bj][m][n])); \
        acc[ai][bj][m][n] = F16 ? __builtin_amdgcn_mfma_f32_16x16x32_f16(__builtin_bit_cast(h16x8, Bt[n][1]), __builtin_bit_cast(h16x8, At[m][1]), acc[ai][bj][m][n], 0, 0, 0) \
                                : __builtin_amdgcn_mfma_f32_16x16x32_bf16(Bt[n][1], At[m][1], acc[ai][bj][m][n], 0, 0, 0); } __builtin_amdgcn_s_setprio(0); } while (0)
#define PG8_WAIT_V(n) asm volatile("s_waitcnt vmcnt(" #n ")" ::: "memory")
#define PG8_WAIT_L(n) asm volatile("s_waitcnt lgkmcnt(" #n ")" ::: "memory")
#define PG8_BAR __builtin_amdgcn_s_barrier()
#define PG8_SCHED __builtin_amdgcn_sched_barrier(0)
    Unit cur, nxt; int ui = 0;
    if (!S.next(0, cur)) return;
    cur.slot = 0;
    float pre = 0.f;
    if constexpr (Epi::HAS_PRE) pre = E.prefetch(cur, ({ int ln_; asm volatile("v_mbcnt_lo_u32_b32 %0, -1, 0\n\tv_mbcnt_hi_u32_b32 %0, -1, %0" : "=v"(ln_)); wid * 64 + ln_; }));
    f32x4 acc[2][2][4][2];
    if constexpr (!(SP2 && PEEL)) {
#pragma unroll
    for (int a = 0; a < 2; ++a)
#pragma unroll
        for (int b = 0; b < 2; ++b)
#pragma unroll
            for (int m = 0; m < 4; ++m)
#pragma unroll
                for (int n = 0; n < 2; ++n) acc[a][b][m][n] = (f32x4){0.f, 0.f, 0.f, 0.f};
    }
    bf16x8 At[4][2], B0[2][2], B1[2][2];
    const char* cA = (const char*)g.A + (size_t)cur.pm * tstepA + (size_t)cur.pn * (size_t)g.apn; const char* cB = (const char*)g.Bt + (size_t)cur.pn * tstepB;
    S.a_ready(cur);
    if constexpr (SP2) {
        PG8_STAGE(PG8_SB(0, 0), cB, voffB); PG8_STAGE(PG8_SB(0, 1), cB + hstepB, voffB); PG8_STAGE(PG8_SA(0, 0), cA, voffA); PG8_STAGE(PG8_SA(0, 1), cA + hstepA, voffA);
        if constexpr (Hook::REAL) {
            PG8_STAGE(PG8_SB(1, 0), cB + kstep, voffB); PG8_STAGE(PG8_SA(1, 0), cA + kstep, voffA); PG8_STAGE(PG8_SB(1, 1), cB + hstepB + kstep, voffB);
            hook();
            if (wr == 1) PG8_BAR;
            PG8_WAIT_V(6); PG8_BAR;
        } else {
        if (wr == 1) PG8_BAR;
        PG8_WAIT_V(2); PG8_BAR;
        PG8_STAGE(PG8_SB(1, 0), cB + kstep, voffB); PG8_STAGE(PG8_SA(1, 0), cA + kstep, voffA); PG8_STAGE(PG8_SB(1, 1), cB + hstepB + kstep, voffB);
        PG8_WAIT_V(6); PG8_BAR;
        }
    } else {
        PG8_STAGE(PG8_SB(0, 0), cB, voffB); PG8_STAGE(PG8_SA(0, 0), cA, voffA); PG8_STAGE(PG8_SB(0, 1), cB + hstepB, voffB); PG8_STAGE(PG8_SA(0, 1), cA + hstepA, voffA);
        if (wr == 1) PG8_BAR;
        PG8_WAIT_V(4); PG8_BAR;
        PG8_STAGE(PG8_SB(1, 0), cB + kstep, voffB); PG8_STAGE(PG8_SA(1, 0), cA + kstep, voffA); PG8_STAGE(PG8_SB(1, 1), cB + hstepB + kstep, voffB);
        PG8_WAIT_V(6); PG8_BAR;
    }
    for (;;) {
        const bool has_next = S.next(ui + 1, nxt);
        const char* nA = has_next ? (const char*)g.A + (size_t)nxt.pm * tstepA + (size_t)nxt.pn * (size_t)g.apn : cA; const char* nB = has_next ? (const char*)g.Bt + (size_t)nxt.pn * tstepB : cB;
#define PG8_PTRS(t) const bool last = ((t) == nt - 2); \
            const char* a1 = cA + (size_t)((t) + 1) * kstep; \
            const char* a2 = last ? nA : cA + (size_t)((t) + 2) * kstep; const char* b2 = last ? nB : cB + (size_t)((t) + 2) * kstep; \
            const char* a3 = a2 + kstep; const char* b3 = b2 + kstep; \
            if (last && has_next) S.a_ready(nxt);
#define PG8_BODY_SP2(MMF) \
            PG8_LDB(B0, 0, 0); PG8_LDB(B1, 0, 1); PG8_SCHED; PG8_LDA(At, 0, 0); PG8_STAGE(PG8_SA(1, 1), a1 + hstepA, voffA); \
            PG8_WAIT_V(8); PG8_WAIT_L(0); PG8_BAR; MMF(0, 0, At, B0); MMF(0, 1, At, B1); PG8_BAR; PG8_SCHED; \
            PG8_LDA(At, 0, 1); PG8_STAGE(PG8_SB(0, 0), b2, voffB); PG8_STAGE(PG8_SB(0, 1), b2 + hstepB, voffB); PG8_STAGE(PG8_SA(0, 0), a2, voffA); \
            PG8_WAIT_V(8); PG8_WAIT_L(0); PG8_BAR; MMF(1, 0, At, B0); MMF(1, 1, At, B1); PG8_BAR; PG8_SCHED; \
            PG8_LDB(B0, 1, 0); PG8_LDB(B1, 1, 1); PG8_SCHED; PG8_LDA(At, 1, 0); PG8_STAGE(PG8_SA(0, 1), a2 + hstepA, voffA); \
            PG8_WAIT_V(8); PG8_WAIT_L(0); PG8_BAR; PG8_MMA(0, 0, At, B0); PG8_MMA(0, 1, At, B1); PG8_BAR; PG8_SCHED; \
            PG8_LDA(At, 1, 1); PG8_STAGE(PG8_SB(1, 0), b3, voffB); PG8_STAGE(PG8_SB(1, 1), b3 + hstepB, voffB); PG8_STAGE(PG8_SA(1, 0), a3, voffA); \
            PG8_WAIT_V(8); PG8_WAIT_L(0); PG8_BAR; PG8_MMA(1, 0, At, B0); PG8_MMA(1, 1, At, B1); PG8_BAR; PG8_SCHED;
        if constexpr (SP2 && PEEL) {
            { PG8_PTRS(0) PG8_BODY_SP2(PG8_MMA0) }
            if constexpr (Epi::HAS_PRE) E.commit(pre, ui, ({ int ln_; asm volatile("v_mbcnt_lo_u32_b32 %0, -1, 0\n\tv_mbcnt_hi_u32_b32 %0, -1, %0" : "=v"(ln_)); wid * 64 + ln_; }));
            for (int t = 2; t < nt; t += 2) { PG8_PTRS(t) PG8_BODY_SP2(PG8_MMA) }
        } else if constexpr (SP2) {
            for (int t = 0; t < nt; t += 2) { PG8_PTRS(t) PG8_BODY_SP2(PG8_MMA) }
        } else {
        for (int t = 0; t < nt; t += 2) {
            PG8_PTRS(t)
            PG8_LDB(B0, 0, 0); PG8_SCHED; PG8_LDA(At, 0, 0); PG8_STAGE(PG8_SA(1, 1), a1 + hstepA, voffA);
            PG8_WAIT_L(8); PG8_BAR; PG8_WAIT_L(0); PG8_MMA(0, 0, At, B0); PG8_BAR; PG8_SCHED;
            PG8_LDB(B1, 0, 1); PG8_STAGE(PG8_SB(0, 0), b2, voffB);
            PG8_BAR; PG8_WAIT_L(0); PG8_MMA(0, 1, At, B1); PG8_BAR;
            PG8_LDA(At, 0, 1); PG8_STAGE(PG8_SA(0, 0), a2, voffA);
            PG8_BAR; PG8_WAIT_L(0); PG8_MMA(1, 0, At, B0); PG8_BAR; PG8_SCHED;
            PG8_STAGE(PG8_SB(0, 1), b2 + hstepB, voffB);
            PG8_WAIT_V(6); PG8_BAR; PG8_MMA(1, 1, At, B1); PG8_BAR;
            PG8_LDB(B0, 1, 0); PG8_SCHED; PG8_LDA(At, 1, 0); PG8_STAGE(PG8_SA(0, 1), a2 + hstepA, voffA);
            PG8_WAIT_L(8); PG8_BAR; PG8_WAIT_L(0); PG8_MMA(0, 0, At, B0); PG8_BAR; PG8_SCHED;
            PG8_LDB(B1, 1, 1); PG8_STAGE(PG8_SB(1, 0), b3, voffB);
            PG8_BAR; PG8_WAIT_L(0); PG8_MMA(0, 1, At, B1); PG8_BAR;
            PG8_LDA(At, 1, 1); PG8_STAGE(PG8_SA(1, 0), a3, voffA);
            PG8_BAR; PG8_WAIT_L(0); PG8_MMA(1, 0, At, B0); PG8_BAR; PG8_SCHED;
            PG8_STAGE(PG8_SB(1, 1), b3 + hstepB, voffB);
            PG8_WAIT_V(6); PG8_BAR; PG8_MMA(1, 1, At, B1); PG8_BAR;
        }
        }
#undef PG8_PTRS
#undef PG8_BODY_SP2
        if constexpr (ALIGN_EPI) { if (wr == 0) PG8_BAR; }
        if constexpr (!Epi::AFTER_DRAIN) {
            int ln; asm volatile("v_mbcnt_lo_u32_b32 %0, -1, 0\n\tv_mbcnt_hi_u32_b32 %0, -1, %0" : "=v"(ln));
            if constexpr (Epi::HAS_PRE) E(acc, cur, wr, wc, ln & 15, ln >> 4, ui); else E(acc, cur, wr, wc, ln & 15, ln >> 4);
            S.done(cur); }
        if (!has_next) break;
        if constexpr (!(SP2 && PEEL)) {
#pragma unroll
        for (int a = 0; a < 2; ++a)
#pragma unroll
            for (int b = 0; b < 2; ++b)
#pragma unroll
                for (int m = 0; m < 4; ++m)
#pragma unroll
                    for (int n = 0; n < 2; ++n) acc[a][b][m][n] = (f32x4){0.f, 0.f, 0.f, 0.f};
        }
        { const int ppm = cur.pm, pslot = cur.slot; cur = nxt; cA = nA; cB = nB; ++ui; cur.slot = (cur.pm == ppm) ? pslot : S.first_same_pm(ui, cur.pm); }
        if constexpr (Epi::HAS_PRE) pre = E.prefetch(cur, ({ int ln_; asm volatile("v_mbcnt_lo_u32_b32 %0, -1, 0\n\tv_mbcnt_hi_u32_b32 %0, -1, %0" : "=v"(ln_)); wid * 64 + ln_; }));
        if constexpr (ALIGN_EPI) { if (wr == 1) PG8_BAR; }
    }
    PG8_WAIT_V(0);
    if constexpr (!ALIGN_EPI) { if (wr == 0) PG8_BAR; }
    PG8_BAR;
#undef PG8_SA
#undef PG8_SB
#undef PG8_STAGE
#undef PG8_LDA
#undef PG8_LDB
#undef PG8_MMA
#undef PG8_MMA0
#undef PG8_WAIT_V
#undef PG8_WAIT_L
#undef PG8_BAR
#undef PG8_SCHED
}
}

namespace attn_body {
using bf16=__hip_bfloat16;
using bf16x8=__attribute__((ext_vector_type(8)))short;
using s16x4=__attribute__((ext_vector_type(4)))short;
using f32x16=__attribute__((ext_vector_type(16)))float;
using f32x4a=__attribute__((ext_vector_type(4)))float;
using u32x4=__attribute__((ext_vector_type(4)))unsigned;
constexpr int NHEAD=16,SEQ=8192,D=64,DM=NHEAD*D;
constexpr int NW=8,QBLK=32,QB=QBLK*NW,KVBLK=64,NQB=SEQ/QB;
__device__ __forceinline__ int crow(int r,int hi){return (r&3)+8*(r>>2)+4*hi;}
#define SBAR() __builtin_amdgcn_sched_barrier(0)
__device__ __forceinline__ void cmask(f32x16&p0,f32x16&p1,int jb,int qrel,int hi){
  const float NEG=-INFINITY; int kb=64*jb+4*hi;
  #pragma unroll
  for(int r=0;r<16;++r){int kv=kb+(r&3)+8*(r>>2); if(kv>qrel)p0[r]=NEG; if(kv+32>qrel)p1[r]=NEG;}
}
constexpr int NSLOT=3, SLOTB=8192;
constexpr int LDS_K=0, LDS_V=NSLOT*SLOTB, LDS_WS=2*NSLOT*SLOTB, LDS_OST=LDS_WS+NW*64*4, LDS_G=LDS_OST+NW*4096, LDS_BYTES=LDS_G+SEQ*4;
__device__ __forceinline__ void glds16(const void*gsrc,unsigned lds_dst){unsigned keep;
  asm volatile("s_mov_b32 %0, m0\n\ts_mov_b32 m0, %2\n\ts_nop 0\n\tglobal_load_lds_dwordx4 %1, off\n\ts_mov_b32 m0, %0":"=&s"(keep):"v"(gsrc),"s"(lds_dst):"memory");}
__device__ __forceinline__ float max3f(float a,float b,float c){float r;asm("v_max3_f32 %0, %1, %2, %3":"=v"(r):"v"(a),"v"(b),"v"(c));return r;}
__device__ __forceinline__ float max2f(float a,float b){float r;asm("v_max_f32_e32 %0, %1, %2":"=v"(r):"v"(a),"v"(b));return r;}
__device__ __forceinline__ float fadd_s(float a,float b){float r;asm("v_add_f32_e32 %0, %1, %2":"=v"(r):"v"(a),"v"(b));return r;}
__device__ __forceinline__ float fsub_s(float a,float b){float r;asm("v_sub_f32_e32 %0, %1, %2":"=v"(r):"v"(a),"v"(b));return r;}
typedef float f32x2_t __attribute__((ext_vector_type(2))); typedef __bf16 bf16x2_t __attribute__((ext_vector_type(2)));
__device__ __forceinline__ unsigned cvtpk_s(float lo,float hi){f32x2_t v={lo,hi};bf16x2_t b=__builtin_convertvector(v,bf16x2_t);return __builtin_bit_cast(unsigned,b);}
#define WAIT_BAR(N) asm volatile("s_waitcnt vmcnt(" #N ") lgkmcnt(0)\n\ts_barrier":::"memory")

__device__ __forceinline__ void qkt(f32x16&p0,f32x16&p1,const char*Kslot,const bf16x8*qr,int r32,int hi){
  const char*kb=Kslot+hi*1024+r32*16;
  #pragma unroll
  for(int d0=0;d0<4;++d0){
    const bf16x8 b0=*reinterpret_cast<const bf16x8*>(kb+d0*2048);
    const bf16x8 b1=*reinterpret_cast<const bf16x8*>(kb+d0*2048+512);
    p0=__builtin_amdgcn_mfma_f32_32x32x16_bf16(b0,qr[d0],p0,0,0,0);p1=__builtin_amdgcn_mfma_f32_32x32x16_bf16(b1,qr[d0],p1,0,0,0);}
}
typedef __attribute__((address_space(3))) const char* lds_cptr;
typedef short v4i16_t __attribute__((ext_vector_type(4)));
__device__ __forceinline__ void kload8(bf16x8*kf,lds_cptr kp){
  kf[0]=*(const __attribute__((address_space(3))) bf16x8*)(kp);      kf[1]=*(const __attribute__((address_space(3))) bf16x8*)(kp+512);
  kf[2]=*(const __attribute__((address_space(3))) bf16x8*)(kp+2048); kf[3]=*(const __attribute__((address_space(3))) bf16x8*)(kp+2560);
  kf[4]=*(const __attribute__((address_space(3))) bf16x8*)(kp+4096); kf[5]=*(const __attribute__((address_space(3))) bf16x8*)(kp+4608);
  kf[6]=*(const __attribute__((address_space(3))) bf16x8*)(kp+6144); kf[7]=*(const __attribute__((address_space(3))) bf16x8*)(kp+6656);
}
__device__ __forceinline__ void kload2(bf16x8*kf,lds_cptr kp,int j){ kf[2*j]=*(const __attribute__((address_space(3))) bf16x8*)(kp+j*2048); kf[2*j+1]=*(const __attribute__((address_space(3))) bf16x8*)(kp+j*2048+512); }
__device__ __forceinline__ s16x4 vtr(lds_cptr p){ return __builtin_bit_cast(s16x4,__builtin_amdgcn_ds_read_tr16_b64_v4i16((__attribute__((address_space(3))) v4i16_t*)p)); }
__device__ __forceinline__ float rowmax(const f32x16&p0,const f32x16&p1){
  float a=max3f(p0[0],p0[1],p1[0]),b=max3f(p0[2],p0[3],p1[1]);a=max3f(a,p1[2],p1[3]);
  #pragma unroll
  for(int r=4;r<16;r+=4){a=max3f(a,p0[r],p0[r+1]);b=max3f(b,p0[r+2],p0[r+3]);a=max3f(a,p1[r],p1[r+1]);b=max3f(b,p1[r+2],p1[r+3]);}
  const float m=max2f(a,b);
  auto rr=__builtin_amdgcn_permlane32_swap(__float_as_uint(m),__float_as_uint(m),false,false);
  return max2f(__uint_as_float(rr[0]),__uint_as_float(rr[1]));
}
__device__ __forceinline__ void pv(f32x16*o,int vb,bf16x8 pa0,bf16x8 pa1,bf16x8 pa2,bf16x8 pa3){
  #pragma unroll
  for(int d0=0;d0<2;++d0){s16x4 lo[4],hi[4];
    #pragma unroll
    for(int ks=0;ks<4;++ks){
      asm volatile("ds_read_b64_tr_b16 %0,%1 offset:%c2":"=&v"(lo[ks]):"v"(vb),"i"(d0*4096+ks*1024):"memory");
      asm volatile("ds_read_b64_tr_b16 %0,%1 offset:%c2":"=&v"(hi[ks]):"v"(vb),"i"(d0*4096+ks*1024+512):"memory");}
    asm volatile("s_waitcnt lgkmcnt(0)":::"memory");SBAR();
    #define PK(k) (bf16x8){lo[k][0],lo[k][1],lo[k][2],lo[k][3],hi[k][0],hi[k][1],hi[k][2],hi[k][3]}
    o[d0]=__builtin_amdgcn_mfma_f32_32x32x16_bf16(pa0,PK(0),o[d0],0,0,0);
    o[d0]=__builtin_amdgcn_mfma_f32_32x32x16_bf16(pa1,PK(1),o[d0],0,0,0);
    o[d0]=__builtin_amdgcn_mfma_f32_32x32x16_bf16(pa2,PK(2),o[d0],0,0,0);
    o[d0]=__builtin_amdgcn_mfma_f32_32x32x16_bf16(pa3,PK(3),o[d0],0,0,0);
    #undef PK
  }
}
typedef __attribute__((address_space(3))) const f32x4a* lds_f4ptr;
__device__ __forceinline__ void pre(f32x16&p0,f32x16&p1,lds_cptr gl,int t,int hi,float c0){
  const lds_cptr gt=gl+(64*t+4*hi)*4;
  #pragma unroll
  for(int a=0;a<4;++a){ const f32x4a g0=*(lds_f4ptr)(gt+a*32), g1=*(lds_f4ptr)(gt+128+a*32);
    #pragma unroll
    for(int i=0;i<4;++i){p0[4*a+i]=c0-g0[i];p1[4*a+i]=c0-g1[i];} }
}
#ifndef ATTN_STORE16
#define ATTN_STORE16(p,v) (*(u32x4*)(p)=(v))
#endif
template<int THRL> __device__ __forceinline__ void attn_unit(int b,int h,int qb,const bf16*Q,const bf16*__restrict__ K,const bf16*__restrict__ V,bf16*O,const float*__restrict__ Gbh,char*shm,const int tid,const float skip,unsigned*qctr,volatile __attribute__((address_space(3))) unsigned*tknext){
  const int lane=tid&63,r32=lane&31,hi=lane>>5; const int wid=__builtin_amdgcn_readfirstlane(tid>>6);
  const long rowbase=(long)b*SEQ; const int q0=qb*QB;
  const bf16*Qw=Q+(rowbase+q0+wid*QBLK)*DM+h*D;
  const unsigned lds0=(unsigned)(uintptr_t)shm;
  float*wsf=(float*)(shm+LDS_WS)+wid*64;
  const lds_cptr shm3=(lds_cptr)shm;
  __attribute__((address_space(3))) float* gw=(__attribute__((address_space(3))) float*)(shm3+LDS_G);
  unsigned nxt_=0u; if(qctr&&tid==0)nxt_=__hip_atomic_fetch_add(qctr,1u,__ATOMIC_RELAXED,__HIP_MEMORY_SCOPE_AGENT);
  for(int i=tid*4;i<q0+QB;i+=NW*64*4) *(__attribute__((address_space(3))) f32x4a*)(gw+i)=*(const f32x4a*)(Gbh+i);
  const float gq=Gbh[q0+wid*QBLK+r32];
  asm volatile("s_waitcnt vmcnt(0) lgkmcnt(0)":::"memory");
  if(qctr&&tid==0)tknext[0]=nxt_;
  asm volatile("s_waitcnt lgkmcnt(0)\n\ts_barrier":::"memory");
  int t0;
  { const int NT0=(q0+QB)/KVBLK; const float gtop=gw[q0];
    int T=lane; const float g1=gw[64*(T<NT0?T:NT0-1)+63]; const bool sk1=(T<NT0)&&(gtop-g1<-skip);
    T+=64; const float g2=gw[64*(T<NT0?T:NT0-1)+63]; const bool sk2=(T<NT0)&&(gtop-g2<-skip);
    t0=(__popcll(__ballot(sk1))+__popcll(__ballot(sk2)))&~1; if(t0>NT0-4)t0=NT0-4; t0=__builtin_amdgcn_readfirstlane(t0); }
  const bf16*Kh=K+(rowbase+(long)t0*KVBLK)*DM+h*D,*Vh=V+(rowbase+(long)t0*KVBLK)*DM+h*D;
  const lds_cptr gl=shm3+LDS_G+t0*KVBLK*4;
  const bf16*ksrc=Kh+(long)lane*DM+wid*8;
  const bf16*vsrc=Vh+(long)(16*(wid&3)+(lane>>2))*DM+(wid>>2)*32+(lane&3)*8;
  const unsigned kdst=lds0+LDS_K+wid*1024, vdst=lds0+LDS_V+wid*1024;
  #define DMA_K(t,slot) glds16(ksrc+(long)(t)*KVBLK*DM,(unsigned)__builtin_amdgcn_readfirstlane(kdst+(slot)))
  #define DMA_V(t,slot) glds16(vsrc+(long)(t)*KVBLK*DM,(unsigned)__builtin_amdgcn_readfirstlane(vdst+(slot)))
  const int vb0=(int)(lds0+LDS_V)+((lane>>4)&1)*32+(lane&3)*8+(4*hi+((lane&15)>>2))*64;
  const char*Kbase=shm+LDS_K; bf16x8 kf[8];
  const lds_cptr kp0=shm3+LDS_K+hi*1024+r32*16; const lds_cptr vp0=shm3+LDS_V+((lane>>4)&1)*32+(lane&3)*8+(4*hi+((lane&15)>>2))*64;
  const int NT=(q0+QB)/KVBLK-t0;
  DMA_K(0,0);DMA_V(0,0);DMA_K(1,SLOTB);
  bf16x8 qr[4];
  #pragma unroll
  for(int d0=0;d0<4;++d0)qr[d0]=*reinterpret_cast<const bf16x8*>(&Qw[(long)r32*DM+d0*16+hi*8]);
  float mhat=0.f,l_reg=0.f;f32x16 o[2];o[0]=f32x16{};o[1]=f32x16{};
  const int qrel=wid*QBLK+r32;
  #define CMASK(P0,P1,t) do{int jb_=(t)-(NT-4); if(jb_>=0&&wid<2*jb_+2)cmask(P0,P1,jb_,qrel,hi);}while(0)
  bool resc=false;
  #define START(P0,P1) do{ const float rm=rowmax(P0,P1); resc=false; \
    { const float dl=rm; mhat=fadd_s(mhat,dl); \
      _Pragma("unroll") for(int r=0;r<16;++r){P0[r]=fsub_s(P0[r],dl);P1[r]=fsub_s(P1[r],dl);} } \
    _Pragma("unroll") for(int r=0;r<16;++r)P0[r]=__builtin_amdgcn_exp2f(P0[r]); }while(0)
  #define RESC() do{ if(resc){ asm volatile("s_waitcnt lgkmcnt(0)":::"memory"); \
      _Pragma("unroll") for(int d_=0;d_<2;++d_) _Pragma("unroll") for(int r=0;r<16;++r)o[d_][r]*=wsf[crow(r,hi)]; } }while(0)
  f32x16 pA0,pA1,pB0,pB1;
  int sl_prev=0,sl_cur=0,sl_next=SLOTB;
  #define ROT() do{sl_prev=sl_cur;sl_cur=sl_next;sl_next=(sl_next==(NSLOT-1)*SLOTB)?0:sl_next+SLOTB;}while(0)
  DMA_K(2,2*SLOTB);
  WAIT_BAR(3);
  pre(pA0,pA1,gl,0,hi,gq);
  qkt(pA0,pA1,Kbase,qr,r32,hi);asm volatile("s_nop 15\n\ts_nop 7":"+v"(pA0),"+v"(pA1));
  CMASK(pA0,pA1,0);
  START(pA0,pA1);
  _Pragma("unroll") for(int r=0;r<16;++r)pA1[r]=__builtin_amdgcn_exp2f(pA1[r]);
  WAIT_BAR(0);
  DMA_K(3,0);DMA_V(1,SLOTB);
  ROT();
  kload8(kf,kp0+sl_cur);
  WAIT_BAR(2);
  s16x4 vlo[8],vhi[8]; u32x4 pw0,pw1,pw2,pw3;
  #define PKW(P,B) cvtpk_s(P[B],P[B+1])
  #define PAF(k) __builtin_bit_cast(bf16x8,pw##k)
  #define VFR(i) (bf16x8){vlo[i][0],vlo[i][1],vlo[i][2],vlo[i][3],vhi[i][0],vhi[i][1],vhi[i][2],vhi[i][3]}
  #define PIN(x) asm volatile("":"+v"(x))
  #define MX3(a,b,c) __builtin_fmaxf(__builtin_fmaxf((a),(b)),(c))
  #define GAPA(MF,A0,A1,A2,A3,W0,W1,PW) do{ MF; sacc+=A0; sacc+=A1; sacc+=A2; sacc+=A3; PIN(sacc); W0; W1; PIN(PW); SBAR(); }while(0)
  #define EX(v) __builtin_amdgcn_exp2f(v)
  #define GAPB(MF,X,B) do{ MF; X[B]=EX(X[B]); X[B+1]=EX(X[B+1]); X[B+2]=EX(X[B+2]); X[B+3]=EX(X[B+3]); PIN(X); SBAR(); }while(0)
  #define VRD(i) do{ vlo[i]=vtr(vp_+(((i)>>2)*4096+((i)&3)*1024)); vhi[i]=vtr(vp_+(((i)>>2)*4096+((i)&3)*1024+512)); }while(0)
  #define KRD(G,j) do{ if(G){ kload2(kf,kp0+sl_next,j); SBAR(); } }while(0)
  #define STEP(C0,C1,P0,P1,t,GK,GV,GL) do{ SBAR(); \
    pre(C0,C1,gl,(t),hi,gq-mhat); SBAR(); \
    const lds_cptr vp_=vp0+sl_prev; \
    VRD(0); SBAR(); float sacc=(P0[0]+P0[1]); \
    GAPA(C0=__builtin_amdgcn_mfma_f32_32x32x16_bf16(kf[0],qr[0],C0,0,0,0), P0[2],P0[3],P0[4],P0[5],     pw0[0]=PKW(P0,0), pw0[1]=PKW(P0,2), pw0); \
    VRD(4); SBAR(); GAPA(C1=__builtin_amdgcn_mfma_f32_32x32x16_bf16(kf[1],qr[0],C1,0,0,0), P0[6],P0[7],P0[8],P0[9],     pw0[2]=PKW(P0,4), pw0[3]=PKW(P0,6), pw0); \
    VRD(1); SBAR(); GAPA(C0=__builtin_amdgcn_mfma_f32_32x32x16_bf16(kf[2],qr[1],C0,0,0,0),   P0[10],P0[11],P0[12],P0[13], pw1[0]=PKW(P0,8), pw1[1]=PKW(P0,10), pw1); \
    VRD(5); SBAR(); GAPA(C1=__builtin_amdgcn_mfma_f32_32x32x16_bf16(kf[3],qr[1],C1,0,0,0),   P0[14],P0[15],P1[0],P1[1],   pw1[2]=PKW(P0,12),pw1[3]=PKW(P0,14), pw1); \
    VRD(2); SBAR(); GAPA(C0=__builtin_amdgcn_mfma_f32_32x32x16_bf16(kf[4],qr[2],C0,0,0,0),   P1[2],P1[3],P1[4],P1[5],     pw2[0]=PKW(P1,0), pw2[1]=PKW(P1,2), pw2); \
    VRD(6); SBAR(); GAPA(C1=__builtin_amdgcn_mfma_f32_32x32x16_bf16(kf[5],qr[2],C1,0,0,0),   P1[6],P1[7],P1[8],P1[9],     pw2[2]=PKW(P1,4), pw2[3]=PKW(P1,6), pw2); \
    VRD(3); SBAR(); GAPA(C0=__builtin_amdgcn_mfma_f32_32x32x16_bf16(kf[6],qr[3],C0,0,0,0),   P1[10],P1[11],P1[12],P1[13], pw3[0]=PKW(P1,8), pw3[1]=PKW(P1,10), pw3); \
    VRD(7); SBAR(); GAPA(C1=__builtin_amdgcn_mfma_f32_32x32x16_bf16(kf[7],qr[3],C1,0,0,0),   P1[14],P1[15],0.f,0.f,       pw3[2]=PKW(P1,12),pw3[3]=PKW(P1,14), pw3); \
    l_reg+=sacc; \
    if(GK){DMA_K((t)+3,sl_cur);} if(GV){DMA_V((t)+1,sl_next);} \
    CMASK(C0,C1,t); \
    { float a=MX3(C0[0],C0[1],C1[0]),b=MX3(C0[2],C0[3],C1[1]); a=MX3(a,C1[2],C1[3]); \
      _Pragma("unroll") for(int r=4;r<16;r+=4){a=MX3(a,C0[r],C0[r+1]);b=MX3(b,C0[r+2],C0[r+3]);a=MX3(a,C1[r],C1[r+1]);b=MX3(b,C1[r+2],C1[r+3]);} \
      float rm=__builtin_fmaxf(a,b); { auto rr=__builtin_amdgcn_permlane32_swap(__float_as_uint(rm),__float_as_uint(rm),false,false); rm=__builtin_fmaxf(__uint_as_float(rr[0]),__uint_as_float(rr[1])); } \
      resc=false; \
      if(__builtin_expect(__any(rm>(float)THRL),0)){ const float dl=__builtin_fmaxf(rm,0.f); mhat+=dl; \
        _Pragma("unroll") for(int r=0;r<16;++r){C0[r]-=dl;C1[r]-=dl;} \
        const float f=__builtin_amdgcn_exp2f(-dl); l_reg*=f; if(hi==0)wsf[r32]=f; resc=true; } } \
    SBAR(); \
    GAPB(o[0]=__builtin_amdgcn_mfma_f32_32x32x16_bf16(PAF(0),VFR(0),o[0],0,0,0), C0,0); \
    GAPB(o[1]=__builtin_amdgcn_mfma_f32_32x32x16_bf16(PAF(0),VFR(4),o[1],0,0,0), C0,4); \
    KRD(GL,0); GAPB(o[0]=__builtin_amdgcn_mfma_f32_32x32x16_bf16(PAF(1),VFR(1),o[0],0,0,0), C0,8); \
    KRD(GL,1); GAPB(o[1]=__builtin_amdgcn_mfma_f32_32x32x16_bf16(PAF(1),VFR(5),o[1],0,0,0), C0,12); \
    KRD(GL,2); GAPB(o[0]=__builtin_amdgcn_mfma_f32_32x32x16_bf16(PAF(2),VFR(2),o[0],0,0,0), C1,0); \
    KRD(GL,3); GAPB(o[1]=__builtin_amdgcn_mfma_f32_32x32x16_bf16(PAF(2),VFR(6),o[1],0,0,0), C1,4); \
    GAPB(o[0]=__builtin_amdgcn_mfma_f32_32x32x16_bf16(PAF(3),VFR(3),o[0],0,0,0), C1,8); \
    GAPB(o[1]=__builtin_amdgcn_mfma_f32_32x32x16_bf16(PAF(3),VFR(7),o[1],0,0,0), C1,12); \
    }while(0)
  int t=1;
  #undef CMASK
  #define CMASK(P0,P1,t) do{}while(0)
  for(;t+5<NT;t+=2){
    STEP(pB0,pB1,pA0,pA1,t,true,true,true);     WAIT_BAR(2); RESC(); ROT();
    STEP(pA0,pA1,pB0,pB1,t+1,true,true,true);   WAIT_BAR(2); RESC(); ROT();
  }
  #undef CMASK
  #define CMASK(P0,P1,t) do{int jb_=(t)-(NT-4); if(jb_>=0&&wid<2*jb_+2)cmask(P0,P1,jb_,qrel,hi);}while(0)
  #define ENDW(tt) do{ if((tt)+3<NT){WAIT_BAR(2);} else if((tt)+2<NT){WAIT_BAR(1);} else {WAIT_BAR(0);} }while(0)
  for(;t+1<NT;t+=2){
    STEP(pB0,pB1,pA0,pA1,t,(t+3<NT),(t+1<NT),(t+1<NT));       ENDW(t);   RESC(); ROT();
    STEP(pA0,pA1,pB0,pB1,t+1,(t+4<NT),(t+2<NT),(t+2<NT));     ENDW(t+1); RESC(); ROT();
  }
  STEP(pB0,pB1,pA0,pA1,NT-1,false,false,false); RESC();
  { float sacc=pB0[0]+pB0[1]; _Pragma("unroll") for(int r=2;r<16;++r)sacc+=pB0[r]; _Pragma("unroll") for(int r=0;r<16;++r)sacc+=pB1[r]; l_reg+=sacc;
    pw0=(u32x4){PKW(pB0,0),PKW(pB0,2),PKW(pB0,4),PKW(pB0,6)};pw1=(u32x4){PKW(pB0,8),PKW(pB0,10),PKW(pB0,12),PKW(pB0,14)};pw2=(u32x4){PKW(pB1,0),PKW(pB1,2),PKW(pB1,4),PKW(pB1,6)};pw3=(u32x4){PKW(pB1,8),PKW(pB1,10),PKW(pB1,12),PKW(pB1,14)};
    SBAR(); pv(o,vb0+sl_cur,PAF(0),PAF(1),PAF(2),PAF(3)); }
  #undef PKW
  #undef PAF
  #undef VFR
  #undef PIN
  #undef MX3
  #undef GAPA
  #undef GAPB
  #undef EX
  #undef VRD
  #undef KRD
  #undef STEP
  #undef ENDW
  {auto rr=__builtin_amdgcn_permlane32_swap(__float_as_uint(l_reg),__float_as_uint(l_reg),false,false);l_reg=__uint_as_float(rr[0])+__uint_as_float(rr[1]);}
  if(hi==0)wsf[32+r32]=l_reg;asm volatile("s_waitcnt lgkmcnt(0)":::"memory");
  float rli[16];
  #pragma unroll
  for(int r=0;r<16;++r)rli[r]=__builtin_amdgcn_rcpf(wsf[32+crow(r,hi)]);
  bf16*Ow=O+(rowbase+q0+wid*QBLK)*DM+h*D;
  { bf16*stg=(bf16*)(shm+LDS_OST)+wid*2048;
    #pragma unroll
    for(int r=0;r<16;++r){const int orow=crow(r,hi);
      #pragma unroll
      for(int d0=0;d0<2;++d0)stg[orow*64+d0*32+r32]=__float2bfloat16(o[d0][r]*rli[r]);}
    asm volatile("s_waitcnt lgkmcnt(0)":::"memory");
    #pragma unroll
    for(int i=0;i<4;++i){const int row=i*8+(lane>>3),ch=lane&7; const u32x4 v=*(const u32x4*)(stg+row*64+ch*8); ATTN_STORE16(Ow+(long)row*DM+ch*8,v);} }
  asm volatile("s_waitcnt lgkmcnt(0)\n\ts_barrier":::"memory");
  #undef DMA_K
  #undef DMA_V
  #undef CMASK
  #undef START
  #undef RESC
  #undef ROT
}
constexpr int ATTN_LDS_BYTES=LDS_BYTES;
struct AttnUnit { int bh; int qb; };
struct StaticOrder {
  int vcu;
  __device__ __forceinline__ explicit StaticOrder(int grid,int block):vcu((block%8)*(grid/8)+block/8){}
  __device__ __forceinline__ bool next(int i,AttnUnit&u)const{ if(i>=8)return false; const int s=vcu&7,k=i&3; u.bh=(vcu>>3)+32*(i>>2); u.qb=(k==0)?s:(k==1)?15-s:(k==2)?16+s:31-s; return true; }
};
#undef SBAR
#undef WAIT_BAR
}

constexpr int NWAVES = 8;
#ifndef MK_PER_PHASE
#define MK_PER_PHASE 0
#endif
constexpr size_t MiB = 1u << 20;
constexpr size_t WS_CTL = 0, CTL_ZERO_BYTES = 64 * 1024;
constexpr size_t WS_VEC = 1 * MiB;
constexpr size_t WS_WFIN = 2 * MiB;
constexpr size_t WS_WFOUT = WS_WFIN + 88 * MiB;
constexpr size_t WS_WQKV = WS_WFOUT + 44 * MiB;
constexpr size_t WS_WGATE = WS_WQKV + 12 * MiB;
constexpr size_t WS_WWO = WS_WGATE + 1 * MiB;
constexpr size_t WS_WPOOL = WS_WWO + 4 * MiB;
constexpr size_t WS_WPROJ = WS_WPOOL + 1 * MiB;
constexpr size_t WS_WGW = WS_WPROJ + 2 * MiB;
constexpr size_t WS_Z = WS_WGW + 8 * MiB;
constexpr size_t WS_ZB0 = WS_Z + 130 * MiB, WS_ZB1 = WS_ZB0 + 65 * MiB;
constexpr size_t WS_ST0 = WS_ZB1 + 65 * MiB, WS_ST1 = WS_ST0 + 9 * MiB;
constexpr size_t WS_R = WS_ST1 + 9 * MiB;
constexpr size_t WS_PB = WS_R + 195 * MiB;
constexpr size_t WS_G = WS_PB + 65 * MiB;
constexpr size_t WS_END = WS_G + 2 * MiB;
static_assert(WS_Z == 162 * MiB && WS_END == 702 * MiB, "d_ws map");
static_assert((size_t)M * D * 4 <= 130 * MiB && (size_t)M * D * 2 <= 65 * MiB && (size_t)M * 64 * 4 <= 9 * MiB && (size_t)M * DFF * 2 <= 195 * MiB && (size_t)4 * M * PLE * 2 <= 65 * MiB, "d_ws sizes");
constexpr int V_ONES = 0, V_ZEROS = 1024, V_FIN = 2048, V_QKV = V_FIN + 8 * 11264, V_GATE = V_QKV + 2 * 6144, V_GW = V_GATE + 64, V_END = V_GW + 4 * 2048;
static_assert(V_END * 4 <= (int)MiB, "vector region");
constexpr size_t O_YP = 0, O_YS = (size_t)MP * D, O_KP = O_YS + (size_t)MS * D, O_VP = O_KP + 2ull * MP * D, O_FP = O_VP + 2ull * MP * D, O_PP = O_FP + 2ull * MP * NH,
                 O_KS = O_PP + 2ull * NB * 15 * D, O_VS = O_KS + 2ull * MS * D, O_FS = O_VS + 2ull * MS * D, O_PS = O_FS + 2ull * MS * NH, O_END = O_PS + 2ull * DECB * 15 * D;
static_assert(O_END == 172564480ull, "output size");
constexpr int CW_BAR = 4096, CW_QUEUE = 8192;
constexpr float FOX_SKIP = 64.0f;
constexpr int RING_OFF = 0, RING_BYTES = 131072, LDSCTL_OFF = RING_BYTES, MISC_OFF = LDSCTL_OFF + 320, STAT_OFF = RING_BYTES + 512, STAT_UNITS = 11, LDS_BYTES = 163840;
constexpr int EVEC_OFF = STAT_OFF + STAT_UNITS * 256 * 8;
static_assert(EVEC_OFF + 2 * 512 * 4 <= LDS_BYTES, "LDS map");

#define GAS __attribute__((address_space(1)))
#define LAS __attribute__((address_space(3)))
typedef unsigned short bf16;
typedef unsigned v4u __attribute__((ext_vector_type(4)));
typedef unsigned v2u __attribute__((ext_vector_type(2)));
typedef float f32x4 __attribute__((ext_vector_type(4)));
typedef float f32x2 __attribute__((ext_vector_type(2)));
typedef short bf16x8 __attribute__((ext_vector_type(8)));
typedef short bf16x4 __attribute__((ext_vector_type(4)));
typedef GAS unsigned gu32;
#define RLX_AGENT __ATOMIC_RELAXED, __HIP_MEMORY_SCOPE_AGENT
#define LDS_WAIT() asm volatile("s_waitcnt lgkmcnt(0)" ::: "memory")
__device__ __forceinline__ unsigned f2bf(float f) { unsigned u = __builtin_bit_cast(unsigned, f); return (u + 0x7fffu + ((u >> 16) & 1u)) >> 16; }
__device__ __forceinline__ unsigned pk2(float lo, float hi) { return f2bf(lo) | (f2bf(hi) << 16); }
__device__ __forceinline__ float bf2f(unsigned b) { return __uint_as_float(b << 16); }

#define XB_TMO      128
#define XB_XCNT(j)  (256  + 64 * (j))
#define XB_XSUB(j)  (1280 + 64 * (j))
#define XB_XGEN(j)  (2304 + 64 * (j))
#define XB_TOP      3328
#define XB_TOPGEN   3392
#define XCD_BAR_WORDS 3456
#define XB_SPIN_CAP (1u << 18)
__device__ __forceinline__ unsigned xb_ld(unsigned* p)              { return __hip_atomic_load(p, __ATOMIC_RELAXED, __HIP_MEMORY_SCOPE_AGENT); }
__device__ __forceinline__ unsigned xb_add(unsigned* p, unsigned v) { return __hip_atomic_fetch_add(p, v, __ATOMIC_RELAXED, __HIP_MEMORY_SCOPE_AGENT); }
__device__ __forceinline__ unsigned xb_xcc_id() { return (unsigned)__builtin_amdgcn_s_getreg((3 << 11) | 20) & 0xFu; }
#define XB_SPIN(cond, bar) do { unsigned _sp = 0; while (cond) { __builtin_amdgcn_s_sleep(1); \
    if ((++_sp & 255u) == 0u) { if (xb_ld(&(bar)[XB_TMO])) break; if (_sp > XB_SPIN_CAP) { atomicAdd(&(bar)[XB_TMO], 1u); break; } } } } while (0)
struct XcdBarrier { unsigned* bar; unsigned x; volatile LAS unsigned* st; };
__device__ __forceinline__ XcdBarrier xcd_barrier_post(unsigned* bar, volatile LAS unsigned* st) {
    XcdBarrier b; b.bar = bar; b.x = xb_xcc_id(); b.st = st;
    if (threadIdx.x == 0) (void)xb_add(&bar[XB_XCNT(b.x)], 1u);
    return b;
}
__device__ __forceinline__ void xcd_barrier_complete(unsigned* bar, unsigned x, unsigned& nloc, unsigned& nx) {
    const unsigned G = gridDim.x * gridDim.y * gridDim.z;
    unsigned sum, cnt, mine, sp = 0u;
    for (;;) {
        sum = 0u; cnt = 0u; mine = 0u;
#pragma unroll
        for (unsigned j = 0; j < 16; ++j) { const unsigned c = xb_ld(&bar[XB_XCNT(j)]); sum += c; cnt += (c > 0u) ? 1u : 0u; mine = (j == x) ? c : mine; }
        if (sum == G) break;
        __builtin_amdgcn_s_sleep(1);
        if ((++sp & 255u) == 0u) { if (xb_ld(&bar[XB_TMO])) break; if (sp > XB_SPIN_CAP) { atomicAdd(&bar[XB_TMO], 1u); break; } }
    }
    nloc = mine > 0u ? mine : 1u; nx = cnt > 0u ? cnt : 1u;
}
__device__ __forceinline__ void xcd_barrier(const XcdBarrier& b) {
    asm volatile("s_waitcnt vmcnt(0)" ::: "memory");
    __syncthreads();
    if (threadIdx.x == 0) {
        unsigned* bar = b.bar; asm volatile("" : "+s"(bar));
        __builtin_amdgcn_s_waitcnt(0);
        unsigned nloc = b.st[0], nx = b.st[1];
        if (nloc == 0u) { xcd_barrier_complete(bar, b.x, nloc, nx); b.st[0] = nloc; b.st[1] = nx; }
        const unsigned old = xb_add(&bar[XB_XSUB(b.x)], 1u);
        const unsigned gen = old / nloc;
        if (old + 1u == (gen + 1u) * nloc) {
            __builtin_amdgcn_fence(__ATOMIC_RELEASE, "agent");
            asm volatile("s_waitcnt vmcnt(0)" ::: "memory");
            const unsigned og = xb_add(&bar[XB_TOP], 1u);
            const unsigned tg = og / nx;
            if (og + 1u == (tg + 1u) * nx) xb_add(&bar[XB_TOPGEN], 1u);
            else XB_SPIN(xb_ld(&bar[XB_TOPGEN]) == tg, bar);
            __builtin_amdgcn_fence(__ATOMIC_ACQUIRE, "agent");
            xb_add(&bar[XB_XGEN(b.x)], 1u);
            asm volatile("s_waitcnt vmcnt(0)" ::: "memory");
        } else {
            XB_SPIN(xb_ld(&bar[XB_XGEN(b.x)]) == gen, bar);
            __builtin_amdgcn_fence(__ATOMIC_ACQUIRE, "agent");
            asm volatile("s_waitcnt vmcnt(0)" ::: "memory");
        }
    }
    __syncthreads();
}

struct Args { const float* in[20]; float* out; unsigned char* ws; int ph_lo, ph_hi; };
struct Base { LAS unsigned char* lds; int wave, G; };
struct Frame {
    LAS unsigned char* lds;
    int tid, lane, wave, vcu, G, bx;
    const float *x_p, *x_s, *ck, *cv, *clf, *spool, *p_p, *p_s, *ln_g, *ln_b, *w_fin, *w_fout, *w_fox, *b_f, *w_o, *w_pool, *pool_scale, *w_proj, *w_gate, *b_gate;
    float* out; unsigned char* ws;
    float* vec;
    float* Z; bf16* R; bf16* PB; float* GT;
};
typedef const Args __attribute__((address_space(4)))* KArgs;
__device__ __forceinline__ Frame mkframe(const Base& B) {
    KArgs ka = (KArgs)__builtin_amdgcn_kernarg_segment_ptr(); asm volatile("" : "+s"(ka));
    int tid; asm volatile("v_mbcnt_lo_u32_b32 %0, -1, 0\n\tv_mbcnt_hi_u32_b32 %0, -1, %0" : "=v"(tid)); tid += B.wave * 64;
    Frame F; F.lds = B.lds; F.tid = tid; F.lane = tid & 63; F.wave = __builtin_amdgcn_readfirstlane(tid >> 6);
    { int g_ = B.G, b_ = blockIdx.x; asm volatile("" : "+s"(g_), "+s"(b_)); F.G = g_; F.bx = b_; F.vcu = (g_ % 8 == 0) ? (b_ % 8) * (g_ / 8) + b_ / 8 : b_; }
#define GP(k) ((const float*)(const GAS float*)ka->in[k])
    F.x_p = GP(0); F.x_s = GP(1); F.ck = GP(2); F.cv = GP(3); F.clf = GP(4); F.spool = GP(5); F.p_p = GP(6); F.p_s = GP(7);
    F.ln_g = GP(8); F.ln_b = GP(9); F.w_fin = GP(10); F.w_fout = GP(11); F.w_fox = GP(12); F.b_f = GP(13); F.w_o = GP(14);
    F.w_pool = GP(15); F.pool_scale = GP(16); F.w_proj = GP(17); F.w_gate = GP(18); F.b_gate = GP(19);
#undef GP
    F.out = (float*)(GAS float*)ka->out; unsigned char* ws = (unsigned char*)(GAS unsigned char*)ka->ws; F.ws = ws;
    F.vec = (float*)(ws + WS_VEC); F.Z = (float*)(ws + WS_Z); F.R = (bf16*)(ws + WS_R); F.PB = (bf16*)(ws + WS_PB); F.GT = (float*)(ws + WS_G);
    return F;
}
__device__ __forceinline__ bf16* zbk(const Frame& F, int k) { return (bf16*)(F.ws + WS_ZB0 + (size_t)(k & 1) * (WS_ZB1 - WS_ZB0)); }
__device__ __forceinline__ float* stk(const Frame& F, int k) { return (float*)(F.ws + WS_ST0 + (size_t)(k & 1) * (WS_ST1 - WS_ST0)); }
__device__ __forceinline__ const float* ln_gk(const Frame& F, int k) { return k == 0 ? F.vec + V_ONES : F.ln_g + (size_t)(k - 1) * D; }
__device__ __forceinline__ const float* ln_bk(const Frame& F, int k) { return k == 0 ? F.vec + V_ZEROS : F.ln_b + (size_t)(k - 1) * D; }
__device__ __forceinline__ float wave_incl_scan(float v, int lane) {
#pragma unroll
    for (int o = 1; o < 64; o <<= 1) { const float t = bperm(v, lane - o); if (lane >= o) v += t; }
    return v;
}
__device__ __forceinline__ void row_stats_full(const float* st, int row, float& mu, float& rs) {
    const f32x4* p = (const f32x4*)(st + (size_t)row * 64);
    float s = 0.f, q = 0.f;
#pragma unroll
    for (int i = 0; i < 16; ++i) { const f32x4 a = p[i]; s += a[0] + a[2]; q += a[1] + a[3]; }
    mu = s * (1.0f / 1024.0f);
    const float var = fmaxf(q * (1.0f / 1024.0f) - mu * mu, 0.f);
    rs = 1.0f / sqrtf(var + LN_EPS);
}

template <class Sched> __device__ __forceinline__ void stats_to_lds(const Frame& F, const Sched& S, const float* st) {
    LAS f32x2* T = (LAS f32x2*)(F.lds + STAT_OFF);
    pg8::Unit u;
    int ppm = -1;
    for (int i = 0; i < STAT_UNITS && S.next(i, u); ++i) {
        if (u.pm == ppm) continue;
        ppm = u.pm;
        if (S.first_same_pm(i, u.pm) != i) continue;
        const int r = F.tid >> 1, h = F.tid & 1;
        const f32x4* p = (const f32x4*)(st + ((size_t)(u.pm * 256 + r) * 64 + h * 32));
        float s = 0.f, q = 0.f;
#pragma unroll
        for (int k = 0; k < 8; ++k) { const f32x4 a = p[k]; s += a[0] + a[2]; q += a[1] + a[3]; }
        const float s2 = bperm(s, F.lane ^ 1), q2 = bperm(q, F.lane ^ 1);
        const float st_ = h ? s2 + s : s + s2, qt_ = h ? q2 + q : q + q2;
        const float mu = st_ * (1.0f / 1024.0f), var = fmaxf(qt_ * (1.0f / 1024.0f) - mu * mu, 0.f);
        if (h == 0) T[i * 256 + r] = (f32x2){mu, 1.0f / sqrtf(var + LN_EPS)};
    }
    __syncthreads();
}

template <class Sched> struct StatsHook { static constexpr bool REAL = true; const Frame& F; const Sched& S; const float* st; __device__ __forceinline__ void operator()() const { stats_to_lds(F, S, st); } };

__device__ __forceinline__ void tr_item(const float* src, int ldsrc, int c0, int K, bf16* dst, const float* g, const float* b, float* gWo, float* bWo, const float* extra, int nvalid, LAS float* scr, int lane, bool f16 = false, int kb = 0, int ke = -1) {
    if (ke < 0) ke = K;
    float gs[4] = {0.f, 0.f, 0.f, 0.f}, bs[4] = {0.f, 0.f, 0.f, 0.f};
    const int c = lane & 7, nb = lane >> 3, nn = lane & 31;
    const float* sp = src + (size_t)(kb + (lane >> 5)) * ldsrc + c0 + nn;
    float cur0[32], cur1[32];
#define TR_LOAD(buf, kk) do { const float* sp_ = sp + (size_t)((kk) - kb) * ldsrc; \
        _Pragma("unroll") for (int i = 0; i < 32; ++i) { buf[i] = (nn < nvalid) ? __builtin_nontemporal_load(sp_) : 0.f; sp_ += 2 * (size_t)ldsrc; asm volatile("" : "+v"(sp_)); } } while (0)
#define TR_STEP(buf, k0) do { \
        _Pragma("unroll") for (int i = 0; i < 32; ++i) scr[(2 * i + (lane >> 5)) * 33 + nn] = buf[i]; \
        if ((k0) + 128 < ke) TR_LOAD(buf, (k0) + 128);               \
        float gk[8], bk[8]; \
        _Pragma("unroll") for (int e = 0; e < 8; ++e) { gk[e] = g ? g[(k0) + 8 * c + e] : 1.0f; bk[e] = b ? b[(k0) + 8 * c + e] : 0.f; } \
        LDS_WAIT(); asm volatile("" ::: "memory"); \
        _Pragma("unroll") for (int j = 0; j < 4; ++j) { const int n = nb + 8 * j; const LAS float* s = scr + (8 * c) * 33 + n; \
            unsigned r[8]; \
            _Pragma("unroll") for (int e = 0; e < 8; ++e) { const float w = s[e * 33]; if (f16) { const _Float16 h = (_Float16)(w * gk[e]); r[e] = __builtin_bit_cast(unsigned short, h); gs[j] += (float)h; } else { r[e] = f2bf(w * gk[e]); gs[j] += bf2f(r[e]); } bs[j] += bk[e] * w; } \
            v4u o; o.x = r[0] | (r[1] << 16); o.y = r[2] | (r[3] << 16); o.z = r[4] | (r[5] << 16); o.w = r[6] | (r[7] << 16); \
            if (n < nvalid) *(GAS v4u*)(dst + (size_t)n * K + (k0) + 8 * c) = o; } \
        LDS_WAIT(); asm volatile("" ::: "memory"); } while (0)
    TR_LOAD(cur0, kb);
    if (kb + 64 < ke) TR_LOAD(cur1, kb + 64);
    for (int k0 = kb; k0 < ke; k0 += 128) {
        TR_STEP(cur0, k0);
        if (k0 + 64 < ke) TR_STEP(cur1, k0 + 64);
    }
#undef TR_LOAD
#undef TR_STEP
    if (gWo) {
#pragma unroll
        for (int j = 0; j < 4; ++j) { float a = gs[j], bb = bs[j];
            a += bperm(a, lane ^ 1); a += bperm(a, lane ^ 2); a += bperm(a, lane ^ 4); bb += bperm(bb, lane ^ 1); bb += bperm(bb, lane ^ 2); bb += bperm(bb, lane ^ 4);
            const int n = nb + 8 * j; if (c == 0 && n < nvalid) { gWo[n] = a; bWo[n] = bb + (extra ? extra[n] : 0.f); } }
    }
}
__device__ __forceinline__ void p0_prologue(Frame& F) {
    LAS float* scr = (LAS float*)(F.lds + RING_OFF + F.wave * 16384);
    const int gw = F.wave * F.G + F.vcu, NGW = F.G * NWAVES;
    constexpr int I_FOUT = 8 * 32 * 4, I_FIN = 8 * 176, I_QKV = 2 * 96, I_WO = 2 * 32, I_GW = 4 * 32, I_PROJ = 4 * 32, I_POOL = 2 * 4 * 8, I_GATE = 2;
    constexpr int NITEMS = I_FOUT + I_FIN + I_QKV + I_WO + I_GW + I_PROJ + I_POOL + I_GATE;
    for (int it = gw; it < NITEMS; it += NGW) {
        int r = it;
        if (r < I_FOUT) { const int f = r / 128, nb = (r % 128) >> 2, kq = r & 3;
            tr_item(F.w_fout + (size_t)f * DFF * D, D, nb * 32, DFF, (bf16*)(F.ws + WS_WFOUT) + (size_t)f * D * DFF + (size_t)nb * 32 * DFF, nullptr, nullptr, nullptr, nullptr, nullptr, 32, scr, F.lane, false, kq * 704, kq * 704 + 704); continue; } r -= I_FOUT;
        if (r < I_FIN) { const int f = r / 176, nb = r % 176, n0 = nb * 32, i = f >> 1, s = f & 1, kin = 4 * i + 2 * s;
            const int pn = n0 >> 8, w = n0 & 255, c0 = (w < 128 ? 0 : DFF) + pn * 128 + (w & 127);
            tr_item(F.w_fin + (size_t)f * D * 2 * DFF, 2 * DFF, c0, D, (bf16*)(F.ws + WS_WFIN) + (size_t)f * 2 * DFF * D + (size_t)n0 * D, kin == 0 ? nullptr : ln_gk(F, kin), kin == 0 ? nullptr : ln_bk(F, kin),
                    F.vec + V_FIN + f * 11264 + n0, F.vec + V_FIN + f * 11264 + 5632 + n0, nullptr, 32, scr, F.lane, !ZBF_E); continue; } r -= I_FIN;
        if (r < I_QKV) { const int j = r / 96, nb = r % 96, n0 = nb * 32, kin = 8 * j + 1;
            tr_item(F.w_fox + (size_t)j * D * 3088, 3088, n0, D, (bf16*)(F.ws + WS_WQKV) + (size_t)j * 3072 * D + (size_t)n0 * D, ln_gk(F, kin), ln_bk(F, kin),
                    F.vec + V_QKV + j * 6144 + n0, F.vec + V_QKV + j * 6144 + 3072 + n0, nullptr, 32, scr, F.lane, !ZBF_O); continue; } r -= I_QKV;
        if (r < I_WO) { const int j = r / 32, nb = r % 32;
            tr_item(F.w_o + (size_t)j * D * D, D, nb * 32, D, (bf16*)(F.ws + WS_WWO) + (size_t)j * D * D + (size_t)nb * 32 * D, nullptr, nullptr, nullptr, nullptr, nullptr, 32, scr, F.lane); continue; } r -= I_WO;
        if (r < I_GW) { const int i = r / 32, nb = r % 32, n0 = nb * 32, kin = 4 * i + 3;
            tr_item(F.w_gate + (size_t)i * D * D, D, n0, D, (bf16*)(F.ws + WS_WGW) + (size_t)i * D * D + (size_t)n0 * D, ln_gk(F, kin), ln_bk(F, kin),
                    F.vec + V_GW + i * 2048 + n0, F.vec + V_GW + i * 2048 + 1024 + n0, F.b_gate + (size_t)i * D + n0, 32, scr, F.lane, !ZBF_O); continue; } r -= I_GW;
        if (r < I_PROJ) { const int i = r / 32, nb = r % 32;
            tr_item(F.w_proj + (size_t)i * PLE * D, D, nb * 32, PLE, (bf16*)(F.ws + WS_WPROJ) + (size_t)i * D * PLE + (size_t)nb * 32 * PLE, nullptr, nullptr, nullptr, nullptr, nullptr, 32, scr, F.lane); continue; } r -= I_PROJ;
        if (r < I_POOL) { const int jg = r / 8, nb = r % 8;
            tr_item(F.w_pool + (size_t)jg * 256 * 256, 256, nb * 32, 256, (bf16*)(F.ws + WS_WPOOL) + (size_t)jg * 256 * 256 + (size_t)nb * 32 * 256, nullptr, nullptr, nullptr, nullptr, nullptr, 32, scr, F.lane); continue; } r -= I_POOL;
        { const int j = r, kin = 8 * j + 1;
            tr_item(F.w_fox + (size_t)j * D * 3088, 3088, 3072, D, (bf16*)(F.ws + WS_WGATE) + (size_t)j * 16 * D, ln_gk(F, kin), ln_bk(F, kin),
                    F.vec + V_GATE + j * 32, F.vec + V_GATE + j * 32 + 16, F.b_f + j * 16, 16, scr, F.lane, !ZBF_O); }
    }
    const size_t gt = (size_t)gw * 64 + F.lane, GT_ = (size_t)NGW * 64;
#define CVT_STREAM(src, dst, n, PK) do { const float* s_ = (src); bf16* d_ = (dst); const size_t n_ = (n); \
        for (size_t e0 = gt * 8; e0 < n_; e0 += GT_ * 32) { f32x4 a_[4], b_[4]; \
            _Pragma("unroll") for (int u_ = 0; u_ < 4; ++u_) { const size_t e = e0 + (size_t)u_ * GT_ * 8; if (e < n_) { a_[u_] = __builtin_nontemporal_load((const f32x4*)(s_ + e)); b_[u_] = __builtin_nontemporal_load((const f32x4*)(s_ + e + 4)); } } \
            _Pragma("unroll") for (int u_ = 0; u_ < 4; ++u_) { const size_t e = e0 + (size_t)u_ * GT_ * 8; if (e < n_) { v4u w; w.x = PK(a_[u_][0], a_[u_][1]); w.y = PK(a_[u_][2], a_[u_][3]); w.z = PK(b_[u_][0], b_[u_][1]); w.w = PK(b_[u_][2], b_[u_][3]); *(GAS v4u*)(d_ + e) = w; } } } } while (0)
    CVT_STREAM(F.x_p, zbk(F, 0), (size_t)MP * D, pkz<ZBF_E>);
    CVT_STREAM(F.x_s, zbk(F, 0) + (size_t)MP * D, (size_t)MS * D, pkz<ZBF_E>);
#pragma unroll 1
    for (int i = 0; i < DEPTH; ++i) {
        CVT_STREAM(F.p_p + (size_t)i * MP * PLE, F.PB + (size_t)i * M * PLE, (size_t)MP * PLE, pk2);
        CVT_STREAM(F.p_s + (size_t)i * MS * PLE, F.PB + ((size_t)i * M + MP) * PLE, (size_t)MS * PLE, pk2);
    }
#undef CVT_STREAM
    { const f32x4 idv = {0.f, 32.0f * (1.0f - LN_EPS), 0.f, 32.0f * (1.0f - LN_EPS)}; float* st0 = stk(F, 0);
      for (size_t e = gt * 4; e < (size_t)M * 64; e += GT_ * 4) *(GAS f32x4*)(st0 + e) = idv; }
    if (gw == 0) { for (int e = F.lane; e < 1024; e += 64) { F.vec[V_ONES + e] = 1.0f; F.vec[V_ZEROS + e] = 0.f; } }
}

__device__ __forceinline__ void ln_row_out(const Frame& F, int k, int m, float* dst) {
    float mu, rs; row_stats_full(stk(F, k), m, mu, rs);
    const GAS v2u* zi = (const GAS v2u*)(zbk(F, k) + (size_t)m * D) + F.lane; const GAS f32x4* gi = (const GAS f32x4*)ln_gk(F, k) + F.lane; const GAS f32x4* bi = (const GAS f32x4*)ln_bk(F, k) + F.lane;
    GAS f32x4* o = (GAS f32x4*)dst + F.lane;
#pragma unroll
    for (int j = 0; j < 4; ++j) { const v2u w = zi[64 * j]; const f32x2g lo_ = upz<ZBF_O>(w.x), hi_ = upz<ZBF_O>(w.y); const f32x4 zv = {lo_.x, lo_.y, hi_.x, hi_.y};
        __builtin_nontemporal_store((zv - mu) * rs * gi[64 * j] + bi[64 * j], (f32x4*)(o + 64 * j)); }
}
__device__ __forceinline__ void gate_proj(const Frame& F, int j, int kin) {
    const int gw = F.vcu * NWAVES + F.wave, NGW = F.G * NWAVES, n16 = F.lane & 15, quad = F.lane >> 4;
    const bf16* A = zbk(F, kin); const bf16* W = (const bf16*)(F.ws + WS_WGATE) + (size_t)j * 16 * D;
    const float gWh = F.vec[V_GATE + j * 32 + n16], bWh = F.vec[V_GATE + j * 32 + 16 + n16];
    for (int it = gw; it < M / 16; it += NGW) {
        const int r0 = it * 16;
        f32x4 acc = {0.f, 0.f, 0.f, 0.f};
        const bf16* ap = A + (size_t)(r0 + n16) * D + 8 * quad; const bf16* wp = W + (size_t)n16 * D + 8 * quad;
#pragma unroll 8
        for (int s = 0; s < 32; ++s) { const bf16x8 a = *(const bf16x8*)(ap + 32 * s), b = *(const bf16x8*)(wp + 32 * s); acc = ZBF_O ? __builtin_amdgcn_mfma_f32_16x16x32_bf16(a, b, acc, 0, 0, 0) : __builtin_amdgcn_mfma_f32_16x16x32_f16(__builtin_bit_cast(h16x8, a), __builtin_bit_cast(h16x8, b), acc, 0, 0, 0); }
        float mu = 0.f, rs = 1.f; if (F.lane < 16) row_stats_full(stk(F, kin), r0 + F.lane, mu, rs);
#pragma unroll
        for (int e = 0; e < 4; ++e) { const int rr = 4 * quad + e; const float m_ = bperm(mu, rr), r_ = bperm(rs, rr);
            const float zl = r_ * (acc[e] - m_ * gWh) + bWh;
            const float t_ = __builtin_amdgcn_exp2f(-LOG2E * fabsf(zl));
            const float l1p = (t_ < 0.03f) ? t_ * (1.0f - t_ * (0.5f - t_ * (0.33333334f - 0.25f * t_))) : __builtin_amdgcn_logf(1.0f + t_) * 0.6931471805599453f;
            const float lf = fminf(zl, 0.f) - l1p;
            const int row = r0 + rr;
            float* o = (row < MP) ? F.out + O_FP + ((size_t)j * MP + row) * NH + n16 : F.out + O_FS + ((size_t)j * MS + (row - MP)) * NH + n16;
            *o = lf; }
    }
}
__device__ __forceinline__ void fox_scan(const Frame& F, int j) {
    if (F.bx >= NB * NH) return;
    const int bh = F.bx, b = bh >> 4, h = bh & 15, t0 = F.tid * 16;
    const float* lf = F.out + O_FP + ((size_t)j * MP + (size_t)b * SEQ + t0) * NH + h;
    LAS float* wt = (LAS float*)(F.lds + RING_OFF);
    float v[16]; float run = 0.f;
#pragma unroll
    for (int i = 0; i < 16; ++i) v[i] = lf[(size_t)i * NH];
#pragma unroll
    for (int i = 0; i < 16; ++i) { run += v[i]; v[i] = run; }
    const float incl = wave_incl_scan(run, F.lane);
    if (F.lane == 63) wt[F.wave] = incl;
    __syncthreads();
    float base = incl - run;
#pragma unroll
    for (int w = 0; w < NWAVES; ++w) if (w < F.wave) base += wt[w];
    float* g = F.GT + (size_t)bh * SEQ + t0;
#pragma unroll
    for (int i = 0; i < 4; ++i) *(GAS f32x4*)(g + 4 * i) = (f32x4){(base + v[4 * i]) * LOG2E, (base + v[4 * i + 1]) * LOG2E, (base + v[4 * i + 2]) * LOG2E, (base + v[4 * i + 3]) * LOG2E};
    __syncthreads();
}
__device__ __forceinline__ void sample_attn_item(const Frame& F, int j, int b, int h) {
    const int n16 = F.lane & 15, quad = F.lane >> 4;
    const float* ck = F.ck + ((size_t)(j * DECB + b) * PAST) * D + h * HD; const float* cv = F.cv + ((size_t)(j * DECB + b) * PAST) * D + h * HD;
    const float* clf = F.clf + ((size_t)(j * DECB + b) * PAST) * NH + h;
    const float* kn = F.out + O_KS + ((size_t)j * MS + b * DECS) * D + h * HD; const float* vn = F.out + O_VS + ((size_t)j * MS + b * DECS) * D + h * HD;
    const float* lfn = F.out + O_FS + ((size_t)j * MS + b * DECS) * NH + h;
    bf16* qo = F.R + (size_t)(MP + b * DECS) * D + h * HD;
    LAS float* Fs = (LAS float*)(F.lds + RING_OFF); LAS float* Wm = Fs + 1088; LAS float* Wl = Wm + 128; LAS float* Wo = (LAS float*)(F.lds + RING_OFF + 8192);
    if (F.wave == 0) {
        float v[17]; float run = 0.f;
#pragma unroll
        for (int e = 0; e < 17; ++e) { const int idx = F.lane * 17 + e; float x = 0.f; if (idx < PAST) x = clf[(size_t)idx * NH]; else if (idx < PAST + DECS) x = lfn[(size_t)(idx - PAST) * NH]; v[e] = x; run += x; }
        float acc = wave_incl_scan(run, F.lane) - run;
#pragma unroll
        for (int e = 0; e < 17; ++e) { const int idx = F.lane * 17 + e; acc += v[e]; if (idx < PAST + DECS) Fs[idx] = acc * LOG2E; }
    }
    __syncthreads();
    bf16x8 qf[2];
#pragma unroll
    for (int s = 0; s < 2; ++s) qf[s] = *(const bf16x8*)(qo + (size_t)n16 * D + 32 * s + 8 * quad);
    const float gq = Fs[PAST + n16];
    float m_run = -INFINITY, l_run = 0.f; f32x4 oacc[4];
#pragma unroll
    for (int d = 0; d < 4; ++d) oacc[d] = (f32x4){0.f, 0.f, 0.f, 0.f};
    for (int T = F.wave; T < 65; T += NWAVES) {
        const float* kb = (T < 64) ? ck + (size_t)(16 * T) * D : kn; const float* vb = (T < 64) ? cv + (size_t)(16 * T) * D : vn;
        const float* kr = kb + (size_t)n16 * D + 8 * quad;
        const f32x4 k0a = __builtin_nontemporal_load((const f32x4*)(kr)), k0b = __builtin_nontemporal_load((const f32x4*)(kr + 4)), k1a = __builtin_nontemporal_load((const f32x4*)(kr + 32)), k1b = __builtin_nontemporal_load((const f32x4*)(kr + 36));
        float vv[4][4];
#pragma unroll
        for (int d = 0; d < 4; ++d)
#pragma unroll
            for (int e = 0; e < 4; ++e) vv[d][e] = __builtin_nontemporal_load(vb + (size_t)(4 * quad + e) * D + 16 * d + n16);
        v4u kw0, kw1; kw0.x = pk2(k0a[0], k0a[1]); kw0.y = pk2(k0a[2], k0a[3]); kw0.z = pk2(k0b[0], k0b[1]); kw0.w = pk2(k0b[2], k0b[3]);
        kw1.x = pk2(k1a[0], k1a[1]); kw1.y = pk2(k1a[2], k1a[3]); kw1.z = pk2(k1b[0], k1b[1]); kw1.w = pk2(k1b[2], k1b[3]);
        f32x4 sc = __builtin_amdgcn_mfma_f32_16x16x32_bf16(__builtin_bit_cast(bf16x8, kw0), qf[0], (f32x4){0.f, 0.f, 0.f, 0.f}, 0, 0, 0);
        sc = __builtin_amdgcn_mfma_f32_16x16x32_bf16(__builtin_bit_cast(bf16x8, kw1), qf[1], sc, 0, 0, 0);
        const f32x4 gk = *(const LAS f32x4*)(Fs + 16 * T + 4 * quad);
#pragma unroll
        for (int e = 0; e < 4; ++e) { sc[e] += gq - gk[e]; if (T == 64 && (4 * quad + e) > n16) sc[e] = -INFINITY; }
        float mx = fmaxf(fmaxf(sc[0], sc[1]), fmaxf(sc[2], sc[3]));
        mx = xmax32(xmax16(mx));
        const float m_new = fmaxf(m_run, mx), scale = __builtin_amdgcn_exp2f(m_run - m_new);
        float p[4]; float ps = 0.f;
#pragma unroll
        for (int e = 0; e < 4; ++e) { p[e] = __builtin_amdgcn_exp2f(sc[e] - m_new); ps += p[e]; }
        l_run = l_run * scale + ps; m_run = m_new;
        v2u pw; pw.x = pk2(p[0], p[1]); pw.y = pk2(p[2], p[3]);
#pragma unroll
        for (int d = 0; d < 4; ++d) { v2u vw; vw.x = pk2(vv[d][0], vv[d][1]); vw.y = pk2(vv[d][2], vv[d][3]);
            oacc[d] = oacc[d] * scale;
            oacc[d] = __builtin_amdgcn_mfma_f32_16x16x16bf16_1k(__builtin_bit_cast(bf16x4, vw), __builtin_bit_cast(bf16x4, pw), oacc[d], 0, 0, 0); }
    }
    const float lt = xadd32(xadd16(l_run));
    if (quad == 0) { Wm[F.wave * 16 + n16] = m_run; Wl[F.wave * 16 + n16] = lt; }
#pragma unroll
    for (int d = 0; d < 4; ++d)
#pragma unroll
        for (int e = 0; e < 4; ++e) Wo[F.wave * 1024 + (16 * d + 4 * quad + e) * 16 + n16] = oacc[d][e];
    __syncthreads();
#pragma unroll
    for (int rep = 0; rep < 2; ++rep) {
        const int e = F.tid + rep * 512, q = e & 15, d = e >> 4;
        float ms = -INFINITY;
#pragma unroll
        for (int w = 0; w < NWAVES; ++w) ms = fmaxf(ms, Wm[w * 16 + q]);
        float num = 0.f, den = 0.f;
#pragma unroll
        for (int w = 0; w < NWAVES; ++w) { const float f = __builtin_amdgcn_exp2f(Wm[w * 16 + q] - ms); num += f * Wo[w * 1024 + e]; den += f * Wl[w * 16 + q]; }
        qo[(size_t)q * D + d] = (bf16)f2bf(num / den);
    }
    __syncthreads();
}
template <int W> __device__ __forceinline__ void pool_group(const Frame& F, const bf16* zsrc, int g, int R0, bool prompt, int t0, const float* hist, float mu_l, float rs_l, const float* gp, const float* bp, bf16* out) {
    const int c = 256 * g + 4 * F.lane;
    const f32x4 gg = *(const f32x4*)(gp + c), bb = *(const f32x4*)(bp + c);
    f32x4 xs[31];
#pragma unroll
    for (int L = 0; L < 31; ++L) {
        if (L < 15 - (W - 1)) continue;
        const int i = L - 15; const float m_ = __uint_as_float(__builtin_amdgcn_readlane(__float_as_uint(mu_l), L)), r_ = __uint_as_float(__builtin_amdgcn_readlane(__float_as_uint(rs_l), L));
        if (i >= 0 || (prompt && t0 + i >= 0)) { const v2u w = *(const GAS v2u*)(zsrc + (size_t)(R0 + i) * D + c); const f32x2g lo_ = upz<ZBF_O>(w.x), hi_ = upz<ZBF_O>(w.y); const f32x4 zv = {lo_.x, lo_.y, hi_.x, hi_.y};
            xs[L] = (zv - m_) * r_ * gg + bb; }
        else if (!prompt) xs[L] = *(const f32x4*)(hist + (size_t)(15 + i) * D + c);
        else xs[L] = (f32x4){0.f, 0.f, 0.f, 0.f};
    }
#pragma unroll
    for (int t = 0; t < 16; ++t) {
        f32x4 s = xs[15 + t];
#pragma unroll
        for (int k = 1; k < W; ++k) s += xs[15 + t - k];
        int cnt = W; if (prompt && t0 + t + 1 < W) cnt = t0 + t + 1;
        const f32x4 pv = s / (float)cnt - xs[15 + t];
        v2u w; w.x = pk2(pv[0], pv[1]); w.y = pk2(pv[2], pv[3]);
        *(GAS v2u*)(out + (size_t)(R0 + t) * D + c) = w;
    }
}
template <int DUMMY> __device__ __forceinline__ void pool_block(const Frame& F, const bf16* zsrc, const float* st, int g, int R0, bool prompt, const float* hist, const float* gp, const float* bp) {
    const int t0 = prompt ? (R0 & (SEQ - 1)) : 0;
    float mu_l = 0.f, rs_l = 1.f;
    { const int i = F.lane - 15; if (F.lane < 31 && (i >= 0 || (prompt && t0 + i >= 0))) row_stats_full(st, R0 + i, mu_l, rs_l); }
    if (g == 0) pool_group<2>(F, zsrc, 0, R0, prompt, t0, hist, mu_l, rs_l, gp, bp, F.R);
    else if (g == 1) pool_group<4>(F, zsrc, 1, R0, prompt, t0, hist, mu_l, rs_l, gp, bp, F.R);
    else if (g == 2) pool_group<8>(F, zsrc, 2, R0, prompt, t0, hist, mu_l, rs_l, gp, bp, F.R);
    else pool_group<16>(F, zsrc, 3, R0, prompt, t0, hist, mu_l, rs_l, gp, bp, F.R);
}
__device__ __forceinline__ void pool_own(const Frame& F, int jp, int kin) {
    const int gw = F.vcu * NWAVES + F.wave, NGW = F.G * NWAVES;
    const float* gp = ln_gk(F, kin); const float* bp = ln_bk(F, kin); const float* st = stk(F, kin); const bf16* zsrc = zbk(F, kin);
    for (int it = gw; it < NB * 15 + DECB * 15; it += NGW) {
        if (it < NB * 15) { const int b = it / 15, i = it % 15; ln_row_out(F, kin, b * SEQ + SEQ - 15 + i, F.out + O_PP + ((size_t)(jp * NB + b) * 15 + i) * D); }
        else { const int w = it - NB * 15, sb = w / 15, i = w % 15; ln_row_out(F, kin, MP + sb * DECS + 1 + i, F.out + O_PS + ((size_t)(jp * DECB + sb) * 15 + i) * D); }
    }
    pg8::StaticOrder S; S.init(MP, D, F.G, F.bx); pg8::Unit u;
    for (int ui = 0; S.next(ui, u); ++ui)
        for (int blk = F.wave; blk < 16; blk += NWAVES) pool_block<0>(F, zsrc, st, u.pn, u.pm * 256 + blk * 16, true, nullptr, gp, bp);
    for (int it = F.bx; it < 16 * (D / 64); it += F.G)
        if (F.wave < 2) { const int R0 = MP + (it & 15) * 32 + F.wave * 16; pool_block<0>(F, zsrc, st, (it >> 4) >> 2, R0, false, F.spool + ((size_t)jp * DECB + (R0 - MP) / DECS) * 15 * D, gp, bp); }
    __syncthreads();
}

enum { SE_SWIGLU = 0, SE_QKV = 1, SE_PP = 2, SE_RES0 = 3, SE_RES1 = 4, SE_RES2 = 5 };
struct SG { const bf16* A; int lda, agrp; const bf16* Bt; int K, ncb;
            const float* st; const float* gW; const float* bW;
            bf16* ob; float* ok;
            const bf16* zp; bf16* zb; float* st_out; const float* st_prev; const float* gp; const float* bp; float cs; const float* vec; const bf16* pp; };
__device__ __forceinline__ float red16(float v, int lane) { v += bperm(v, lane ^ 1); v += bperm(v, lane ^ 2); v += bperm(v, lane ^ 4); v += bperm(v, lane ^ 8); return v; }
#ifndef STAGGER
#define STAGGER 2
#endif
#ifndef PROBE_DUP
#define PROBE_DUP 0
#endif
template <int MODE, int NSTEPS, bool INBF, bool OUTBF> __device__ __forceinline__ void small_gemm(const Frame& F, const SG g, const int when) {
    if (STAGGER == 2 ? (when != 1) : !STAGGER ? (when != 0) : ((((F.bx >> 3) & 1) ^ when) == 0)) return;
    constexpr bool DUAL = (MODE == SE_SWIGLU), AF16 = (MODE == SE_SWIGLU) ? !ZBF_E : (MODE == SE_QKV || MODE == SE_RES2) ? !ZBF_O : false;
    constexpr int BS = DUAL ? 2 : 4, NB_ = (NSTEPS + BS - 1) / BS;
    const int n16 = F.lane & 15, quad = F.lane >> 4, ks = g.K >> 3, kbeg = F.wave * ks;
    LAS float* P = (LAS float*)(F.lds + RING_OFF);
    for (int rep_ = 0; rep_ < ((PROBE_DUP == 13) ? 2 : 1); ++rep_)
    for (int it = F.bx; it < 16 * g.ncb; it += F.G) {
        const int rb = it & 15, cb = it >> 4, row0 = MP + rb * 32;
        const int brow0 = DUAL ? 256 * (cb >> 1) + 64 * (cb & 1) : 64 * cb;
        const bf16* ap = g.A + (size_t)(row0 + n16) * g.lda + (g.agrp ? 256 * (cb >> 2) : 0) + kbeg + 8 * quad;
        const bf16* bp_ = g.Bt + (size_t)(brow0 + n16) * g.K + kbeg + 8 * quad;
        const int r = F.tid >> 4, c4 = (F.tid & 15) * 4, R = row0 + r, col = 64 * cb + c4; const size_t off = (size_t)R * D + col;
        f32x4 p4 = {0.f, 0.f, 0.f, 0.f}, va = {0.f, 0.f, 0.f, 0.f}, vb = {0.f, 0.f, 0.f, 0.f}, vc = {0.f, 0.f, 0.f, 0.f}, vd = {0.f, 0.f, 0.f, 0.f}; v2u zw = {0u, 0u}, pw = {0u, 0u};
        if (MODE != SE_PP) p4 = *(const f32x4*)(((MODE == SE_SWIGLU || MODE == SE_QKV) ? g.st : g.st_prev) + (size_t)R * 64 + 4 * (F.tid & 15));
        if (MODE == SE_SWIGLU) { const int arow = brow0 + c4; va = *(const f32x4*)(g.bW + arow); vb = *(const f32x4*)(g.gW + arow); vc = *(const f32x4*)(g.bW + arow + 128); vd = *(const f32x4*)(g.gW + arow + 128); }
        if (MODE == SE_QKV || MODE == SE_RES2) { va = *(const f32x4*)(g.bW + col); vb = *(const f32x4*)(g.gW + col); }
        if (MODE == SE_RES0 || MODE == SE_RES1 || MODE == SE_RES2) { zw = *(const GAS v2u*)(g.zp + off); vc = *(const f32x4*)(g.gp + col); vd = *(const f32x4*)(g.bp + col); }
        if (MODE == SE_RES1) va = *(const f32x4*)(g.vec + col);
        if (MODE == SE_RES2) pw = *(const GAS v2u*)(g.pp + off);
        f32x4 acc[2][4], accu[2][4];
#pragma unroll
        for (int mt = 0; mt < 2; ++mt)
#pragma unroll
            for (int nt = 0; nt < 4; ++nt) { acc[mt][nt] = (f32x4){0.f, 0.f, 0.f, 0.f}; accu[mt][nt] = (f32x4){0.f, 0.f, 0.f, 0.f}; }
        bf16x8 fa[2][BS][2], fb[2][BS][4], fu[2][BS][4];
#define SG_LOAD(buf, b0_) do { _Pragma("unroll") for (int s_ = 0; s_ < BS; ++s_) if ((b0_) * BS + s_ < NSTEPS) { const int ko = 32 * ((b0_) * BS + s_); \
            _Pragma("unroll") for (int mt = 0; mt < 2; ++mt) fa[buf][s_][mt] = *(const bf16x8*)(ap + (size_t)(16 * mt) * g.lda + ko); \
            _Pragma("unroll") for (int nt = 0; nt < 4; ++nt) { fb[buf][s_][nt] = *(const bf16x8*)(bp_ + (size_t)(16 * nt) * g.K + ko); if (DUAL) fu[buf][s_][nt] = *(const bf16x8*)(bp_ + (size_t)(128 + 16 * nt) * g.K + ko); } } } while (0)
        SG_LOAD(0, 0);
#pragma unroll
        for (int b = 0; b < NB_; ++b) {
            if (b + 1 < NB_) SG_LOAD((b + 1) & 1, b + 1);
#pragma unroll
            for (int s_ = 0; s_ < BS; ++s_) if (b * BS + s_ < NSTEPS) {
#pragma unroll
                for (int mt = 0; mt < 2; ++mt)
#pragma unroll
                    for (int nt = 0; nt < 4; ++nt) {
                        if (AF16) acc[mt][nt] = __builtin_amdgcn_mfma_f32_16x16x32_f16(__builtin_bit_cast(h16x8, fb[b & 1][s_][nt]), __builtin_bit_cast(h16x8, fa[b & 1][s_][mt]), acc[mt][nt], 0, 0, 0);
                        else acc[mt][nt] = __builtin_amdgcn_mfma_f32_16x16x32_bf16(fb[b & 1][s_][nt], fa[b & 1][s_][mt], acc[mt][nt], 0, 0, 0);
                        if (DUAL) accu[mt][nt] = AF16 ? __builtin_amdgcn_mfma_f32_16x16x32_f16(__builtin_bit_cast(h16x8, fu[b & 1][s_][nt]), __builtin_bit_cast(h16x8, fa[b & 1][s_][mt]), accu[mt][nt], 0, 0, 0) : __builtin_amdgcn_mfma_f32_16x16x32_bf16(fu[b & 1][s_][nt], fa[b & 1][s_][mt], accu[mt][nt], 0, 0, 0);
                    }
            }
        }
#undef SG_LOAD
#pragma unroll
        for (int mt = 0; mt < 2; ++mt)
#pragma unroll
            for (int nt = 0; nt < 4; ++nt) { const int o = F.wave * 2048 + (16 * mt + n16) * 64 + (((4 * nt + quad) ^ n16) << 2); *(LAS f32x4*)(P + o) = acc[mt][nt]; if (DUAL) *(LAS f32x4*)(P + 16384 + o) = accu[mt][nt]; }
        asm volatile("s_waitcnt lgkmcnt(0)\n\ts_barrier" ::: "memory");
        f32x4 v = {0.f, 0.f, 0.f, 0.f}, vu = {0.f, 0.f, 0.f, 0.f};
        { const int o = r * 64 + ((((F.tid & 15)) ^ (r & 15)) << 2);
#pragma unroll
          for (int w = 0; w < NWAVES; ++w) { v += *(const LAS f32x4*)(P + w * 2048 + o); if (DUAL) vu += *(const LAS f32x4*)(P + 16384 + w * 2048 + o); } }
        float mu = 0.f, rs = 1.f;
        if (MODE != SE_PP) {
            const float s_ = red16(p4[0] + p4[2], F.lane), q_ = red16(p4[1] + p4[3], F.lane);
            mu = s_ * (1.0f / 1024.0f); rs = 1.0f / sqrtf(fmaxf(q_ * (1.0f / 1024.0f) - mu * mu, 0.f) + LN_EPS);
        }
        const float mr = mu * rs;
        if (MODE == SE_SWIGLU) {
            f32x4 a_ = v * rs + (va - mr * vb);
            const f32x4 u_ = vu * rs + (vc - mr * vd);
#pragma unroll
            for (int e = 0; e < 4; ++e) a_[e] = a_[e] * __builtin_amdgcn_rcpf(1.0f + __builtin_amdgcn_exp2f(-LOG2E * a_[e])) * u_[e];
            v2u w; w.x = pg8::cvt_pk_bf16(a_[0], a_[1]); w.y = pg8::cvt_pk_bf16(a_[2], a_[3]);
            *(GAS v2u*)(g.ob + (size_t)R * DFF + col) = w;
        } else if (MODE == SE_QKV) {
            const int t = col >> 10, cc = col & 1023;
            const f32x4 y = v * rs + (va - mr * vb);
            const float sc = (t == 0) ? C2 : 1.0f;
            v2u w; w.x = pg8::cvt_pk_bf16(y[0] * sc, y[1] * sc); w.y = pg8::cvt_pk_bf16(y[2] * sc, y[3] * sc);
            *(GAS v2u*)(g.ob + (size_t)t * ((size_t)M * D) + (size_t)R * D + cc) = w;
            if (t != 0) *(GAS f32x4*)(g.ok + (t == 2 ? 2ull * MS * D : 0ull) + (size_t)(R - MP) * D + cc) = y;
        } else if (MODE == SE_PP) {
            v2u w; w.x = pg8::cvt_pk_bf16(v[0], v[1]); w.y = pg8::cvt_pk_bf16(v[2], v[3]);
            *(GAS v2u*)(g.ob + off) = w;
        } else {
            const f32x2g zl_ = upz<INBF>(zw.x), zh_ = upz<INBF>(zw.y); const f32x4 zi = {zl_.x, zl_.y, zh_.x, zh_.y};
            const f32x4 xa = ((zi * rs - mr) * vc + vd) * ALPHA;
            f32x4 zn;
            if (MODE == SE_RES0) zn = xa + v * g.cs;
            else if (MODE == SE_RES1) zn = xa + v * va;
            else {
                f32x4 y = v * rs + (va - mr * vb);
#pragma unroll
                for (int e = 0; e < 4; ++e) y[e] = __builtin_amdgcn_rcpf(1.0f + __builtin_amdgcn_exp2f(-LOG2E * y[e]));
                f32x4 pf; pf[0] = __uint_as_float(pw.x << 16); pf[1] = __uint_as_float(pw.x & 0xffff0000u); pf[2] = __uint_as_float(pw.y << 16); pf[3] = __uint_as_float(pw.y & 0xffff0000u);
                zn = xa + pf * y;
            }
            v2u w; w.x = pkz<OUTBF>(zn[0], zn[1]); w.y = pkz<OUTBF>(zn[2], zn[3]);
            *(GAS v2u*)(g.zb + off) = w;
            { const f32x2g a_ = upz<OUTBF>(w.x), b_ = upz<OUTBF>(w.y); zn = (f32x4){a_.x, a_.y, b_.x, b_.y}; }
            const float s_ = red16((zn[0] + zn[1]) + (zn[2] + zn[3]), F.lane), q_ = red16((zn[0] * zn[0] + zn[1] * zn[1]) + (zn[2] * zn[2] + zn[3] * zn[3]), F.lane);
            if ((F.tid & 15) == 0) *(GAS f32x4*)(g.st_out + (size_t)R * 64 + 4 * cb) = (f32x4){s_, q_, 0.f, 0.f};
        }
        asm volatile("s_waitcnt lgkmcnt(0)\n\ts_barrier" ::: "memory");
    }
}

#ifndef PEEL_FIN
#define PEEL_FIN 1
#define PEEL_FOUT 1
#define PEEL_QKV 1
#define PEEL_OPROJ 1
#define PEEL_POOL 1
#define PEEL_PLEA 1
#define PEEL_PLEB 0
#endif
#define RING(F) ((PG8_LAS unsigned char*)((F).lds + RING_OFF))
__device__ __forceinline__ void ph_ffn_in(const Frame& F, int i, int s, int dry = 0) {
    const int f = i * 2 + s, kin = 4 * i + 2 * s;
    pg8::Gemm g{zbk(F, kin), (const bf16*)(F.ws + WS_WFIN) + (size_t)f * 2 * DFF * D, MP, 2 * DFF, D, D, 0}; pg8::StaticOrder S; S.init(MP, 2 * DFF, F.G, F.bx);
    pg8::EpiSwiglu E{F.R, (pg8::StatTab)(F.lds + STAT_OFF), F.vec + V_FIN + f * 11264, F.vec + V_FIN + f * 11264 + 5632, dry, (PG8_LAS float*)(F.lds + EVEC_OFF)};
    pg8::gemm_phase<pg8::EpiSwiglu, pg8::StaticOrder, true, true, !ZBF_E, PEEL_FIN, StatsHook<pg8::StaticOrder>>(RING(F), g, S, E, F.tid, StatsHook<pg8::StaticOrder>{F, S, stk(F, kin)});
}
__device__ __forceinline__ void ph_ffn_out(const Frame& F, int i, int s, int dry = 0) {
    const int f = i * 2 + s, kin = 4 * i + 2 * s, kout = kin + 1;
    pg8::Gemm g{F.R, (const bf16*)(F.ws + WS_WFOUT) + (size_t)f * D * DFF, MP, D, DFF, DFF, 0}; pg8::StaticOrder S; S.init(MP, D, F.G, F.bx);
    pg8::EpiRes<0, ZBF_E, ZBF_O> E{zbk(F, kin), zbk(F, kout), stk(F, kout), (pg8::StatTab)(F.lds + STAT_OFF), ln_gk(F, kin), ln_bk(F, kin), 0.5f, nullptr, nullptr, nullptr, nullptr, dry};
    stats_to_lds(F, S, stk(F, kin));
    pg8::gemm_phase<pg8::EpiRes<0, ZBF_E, ZBF_O>, pg8::StaticOrder, true, true, false, PEEL_FOUT>(RING(F), g, S, E, F.tid);
}
__device__ __forceinline__ void ph_qkv(const Frame& F, int i) {
    const int j = i >> 1, kin = 4 * i + 1;
    pg8::Gemm g{zbk(F, kin), (const bf16*)(F.ws + WS_WQKV) + (size_t)j * 3072 * D, MP, 3072, D, D, 0}; pg8::StaticOrder S; S.init(MP, 3072, F.G, F.bx);
    static_assert(O_VP - O_KP == 2ull * MP * D && O_VS - O_KS == 2ull * MS * D, "EpiQKV output arithmetic");
    pg8::EpiQKV E{F.R, F.out + O_KP + (size_t)j * MP * D, F.out + O_KS + (size_t)j * MS * D, (pg8::StatTab)(F.lds + STAT_OFF), F.vec + V_QKV + j * 6144, F.vec + V_QKV + j * 6144 + 3072};
    pg8::gemm_phase<pg8::EpiQKV, pg8::StaticOrder, true, true, !ZBF_O, PEEL_QKV, StatsHook<pg8::StaticOrder>>(RING(F), g, S, E, F.tid, StatsHook<pg8::StaticOrder>{F, S, stk(F, kin)});
}
__device__ __forceinline__ void ph_oproj(const Frame& F, int i) {
    const int j = i >> 1, kin = 4 * i + 1, kout = kin + 1;
    pg8::Gemm g{F.R, (const bf16*)(F.ws + WS_WWO) + (size_t)j * D * D, MP, D, D, D, 0}; pg8::StaticOrder S; S.init(MP, D, F.G, F.bx);
    pg8::EpiRes<0, ZBF_O, ZBF_E> E{zbk(F, kin), zbk(F, kout), stk(F, kout), (pg8::StatTab)(F.lds + STAT_OFF), ln_gk(F, kin), ln_bk(F, kin), 1.0f, nullptr, nullptr, nullptr, nullptr, 0};
    stats_to_lds(F, S, stk(F, kin));
    pg8::gemm_phase<pg8::EpiRes<0, ZBF_O, ZBF_E>, pg8::StaticOrder, true, true, false, PEEL_OPROJ>(RING(F), g, S, E, F.tid);
}
__device__ __forceinline__ void ph_poolgemm(const Frame& F, int i) {
    const int jp = i >> 1, kin = 4 * i + 1, kout = kin + 1;
    pg8::Gemm g{F.R, (const bf16*)(F.ws + WS_WPOOL) + (size_t)jp * D * 256, MP, D, 256, D, 512}; pg8::StaticOrder S; S.init(MP, D, F.G, F.bx);
    pg8::EpiRes<1, ZBF_O, ZBF_E> E{zbk(F, kin), zbk(F, kout), stk(F, kout), (pg8::StatTab)(F.lds + STAT_OFF), ln_gk(F, kin), ln_bk(F, kin), 1.0f, F.pool_scale + (size_t)jp * D, nullptr, nullptr, nullptr, 0};
    stats_to_lds(F, S, stk(F, kin));
    pg8::gemm_phase<pg8::EpiRes<1, ZBF_O, ZBF_E>, pg8::StaticOrder, true, true, false, PEEL_POOL>(RING(F), g, S, E, F.tid);
}
__device__ __forceinline__ void ph_ple_a(const Frame& F, int i) {
    { pg8::Gemm g{F.PB + (size_t)i * M * PLE, (const bf16*)(F.ws + WS_WPROJ) + (size_t)i * D * PLE, MP, D, PLE, PLE, 0}; pg8::StaticOrder S; S.init(MP, D, F.G, F.bx);
      pg8::EpiStoreBf16 E{F.R};
      pg8::gemm_phase<pg8::EpiStoreBf16, pg8::StaticOrder, true, true, false, PEEL_PLEA>(RING(F), g, S, E, F.tid); }
}
__device__ __forceinline__ void ph_ple_b(const Frame& F, int i) {
    const int kin = 4 * i + 3, kout = kin + 1;
    { pg8::Gemm g{zbk(F, kin), (const bf16*)(F.ws + WS_WGW) + (size_t)i * D * D, MP, D, D, D, 0}; pg8::StaticOrder S; S.init(MP, D, F.G, F.bx);
      pg8::EpiRes<2, ZBF_O, ZBF_E> E{zbk(F, kin), zbk(F, kout), stk(F, kout), (pg8::StatTab)(F.lds + STAT_OFF), ln_gk(F, kin), ln_bk(F, kin), 1.0f, nullptr, F.vec + V_GW + i * 2048, F.vec + V_GW + i * 2048 + 1024, F.R, 0};
      stats_to_lds(F, S, stk(F, kin));
      pg8::gemm_phase<pg8::EpiRes<2, ZBF_O, ZBF_E>, pg8::StaticOrder, true, true, !ZBF_O, PEEL_PLEB>(RING(F), g, S, E, F.tid); }
}

__device__ __forceinline__ void ps_ffn_in(const Frame& F, int i, int s, int when) {
    const int f = i * 2 + s, kin = 4 * i + 2 * s;
    SG g{}; g.A = zbk(F, kin); g.lda = D; g.Bt = (const bf16*)(F.ws + WS_WFIN) + (size_t)f * 2 * DFF * D; g.K = D; g.ncb = DFF / 64;
    g.st = stk(F, kin); g.gW = F.vec + V_FIN + f * 11264; g.bW = F.vec + V_FIN + f * 11264 + 5632; g.ob = F.R;
    small_gemm<SE_SWIGLU, 4, false, false>(F, g, when);
}
__device__ __forceinline__ void ps_ffn_out(const Frame& F, int i, int s, int when) {
    const int f = i * 2 + s, kin = 4 * i + 2 * s, kout = kin + 1;
    SG g{}; g.A = F.R; g.lda = DFF; g.Bt = (const bf16*)(F.ws + WS_WFOUT) + (size_t)f * D * DFF; g.K = DFF; g.ncb = D / 64;
    g.zp = zbk(F, kin); g.zb = zbk(F, kout); g.st_out = stk(F, kout); g.st_prev = stk(F, kin); g.gp = ln_gk(F, kin); g.bp = ln_bk(F, kin); g.cs = 0.5f;
    small_gemm<SE_RES0, 11, ZBF_E, ZBF_O>(F, g, when);
}
__device__ __forceinline__ void ps_qkv(const Frame& F, int i, int when) {
    const int j = i >> 1, kin = 4 * i + 1;
    SG g{}; g.A = zbk(F, kin); g.lda = D; g.Bt = (const bf16*)(F.ws + WS_WQKV) + (size_t)j * 3072 * D; g.K = D; g.ncb = 3072 / 64;
    g.st = stk(F, kin); g.gW = F.vec + V_QKV + j * 6144; g.bW = F.vec + V_QKV + j * 6144 + 3072; g.ob = F.R; g.ok = F.out + O_KS + (size_t)j * MS * D;
    small_gemm<SE_QKV, 4, false, false>(F, g, when);
}
__device__ __forceinline__ void ps_oproj(const Frame& F, int i, int when) {
    const int j = i >> 1, kin = 4 * i + 1, kout = kin + 1;
    SG g{}; g.A = F.R; g.lda = D; g.Bt = (const bf16*)(F.ws + WS_WWO) + (size_t)j * D * D; g.K = D; g.ncb = D / 64;
    g.zp = zbk(F, kin); g.zb = zbk(F, kout); g.st_out = stk(F, kout); g.st_prev = stk(F, kin); g.gp = ln_gk(F, kin); g.bp = ln_bk(F, kin); g.cs = 1.0f;
    small_gemm<SE_RES0, 4, ZBF_O, ZBF_E>(F, g, when);
}
__device__ __forceinline__ void ps_poolgemm(const Frame& F, int i, int when) {
    const int jp = i >> 1, kin = 4 * i + 1, kout = kin + 1;
    SG g{}; g.A = F.R; g.lda = D; g.agrp = 1; g.Bt = (const bf16*)(F.ws + WS_WPOOL) + (size_t)jp * D * 256; g.K = 256; g.ncb = D / 64;
    g.zp = zbk(F, kin); g.zb = zbk(F, kout); g.st_out = stk(F, kout); g.st_prev = stk(F, kin); g.gp = ln_gk(F, kin); g.bp = ln_bk(F, kin); g.vec = F.pool_scale + (size_t)jp * D;
    small_gemm<SE_RES1, 1, ZBF_O, ZBF_E>(F, g, when);
}
__device__ __forceinline__ void ps_ple_a(const Frame& F, int i, int when) {
    SG g{}; g.A = F.PB + (size_t)i * M * PLE; g.lda = PLE; g.Bt = (const bf16*)(F.ws + WS_WPROJ) + (size_t)i * D * PLE; g.K = PLE; g.ncb = D / 64; g.ob = F.R;
    small_gemm<SE_PP, 1, false, false>(F, g, when);
}
__device__ __forceinline__ void ps_ple_b(const Frame& F, int i, int when) {
    const int kin = 4 * i + 3, kout = kin + 1;
    SG g{}; g.A = zbk(F, kin); g.lda = D; g.Bt = (const bf16*)(F.ws + WS_WGW) + (size_t)i * D * D; g.K = D; g.ncb = D / 64;
    g.gW = F.vec + V_GW + i * 2048; g.bW = F.vec + V_GW + i * 2048 + 1024; g.pp = F.R;
    g.zp = zbk(F, kin); g.zb = zbk(F, kout); g.st_out = stk(F, kout); g.st_prev = stk(F, kin); g.gp = ln_gk(F, kin); g.bp = ln_bk(F, kin);
    small_gemm<SE_RES2, 4, ZBF_O, ZBF_E>(F, g, when);
}

__global__ void __launch_bounds__(NWAVES * 64, 2) fwd_kernel(Args args) {
    extern __shared__ __attribute__((aligned(16))) unsigned char lds[];
    Base B;
    B.lds = (LAS unsigned char*)lds;
    volatile LAS unsigned* MISC = (volatile LAS unsigned*)(B.lds + MISC_OFF);
    B.wave = __builtin_amdgcn_readfirstlane((int)threadIdx.x >> 6);
    B.G = gridDim.x;
    for (int u = threadIdx.x; u < (STAT_OFF - LDSCTL_OFF) / 4; u += NWAVES * 64) ((LAS unsigned*)(B.lds + LDSCTL_OFF))[u] = 0u;
    __syncthreads();
    XcdBarrier bar; bar.bar = (unsigned*)(args.ws + WS_CTL) + CW_BAR; bar.x = 0; bar.st = nullptr;
    if (!MK_PER_PHASE) bar = xcd_barrier_post((unsigned*)(args.ws + WS_CTL) + CW_BAR, MISC + 8);
    const int lo = args.ph_lo, hi = args.ph_hi;
#define IN(k) (lo <= (k) && (k) < hi)
#define RUN(kind) for (int r_ = 0; r_ < ((PROBE_DUP == (kind)) ? 2 : 1); ++r_)
#define SEAM() do { if (!MK_PER_PHASE) xcd_barrier(bar); } while (0)

    if (IN(0)) { RUN(8) { Frame F = mkframe(B); p0_prologue(F); } SEAM(); }
    for (int i = 0; i < DEPTH; ++i) {
        const int pb = 1 + 10 * i;
        if (IN(pb + 0)) { if (PROBE_DUP == 11) { const Frame F = mkframe(B); ph_ffn_in(F, i, 0, F.G > 0); } RUN(1) { { const Frame F = mkframe(B); ps_ffn_in(F, i, 0, 0); } { const Frame F = mkframe(B); ph_ffn_in(F, i, 0); } { const Frame F = mkframe(B); ps_ffn_in(F, i, 0, 1); } } SEAM(); }
        if (IN(pb + 1)) { if (PROBE_DUP == 12) { const Frame F = mkframe(B); ph_ffn_out(F, i, 0, F.G > 0); } RUN(2) { { const Frame F = mkframe(B); ps_ffn_out(F, i, 0, 0); } { const Frame F = mkframe(B); ph_ffn_out(F, i, 0); } { const Frame F = mkframe(B); ps_ffn_out(F, i, 0, 1); } } SEAM(); }
        if ((i & 1) == 0) {
            const int j = i >> 1, kin = 4 * i + 1;
            if (IN(pb + 2)) { RUN(3) { { const Frame F = mkframe(B); ps_qkv(F, i, 0); } { const Frame F = mkframe(B); ph_qkv(F, i); } { const Frame F = mkframe(B); ps_qkv(F, i, 1); } { const Frame F = mkframe(B); gate_proj(F, j, kin); } } SEAM(); }
            if (IN(pb + 3)) { RUN(9) { const Frame F = mkframe(B); fox_scan(F, j); } SEAM(); }
            if (IN(pb + 4)) {
                volatile LAS unsigned* tk = MISC + 16;
                for (int pass_ = ((PROBE_DUP == 14) ? 0 : 1); pass_ < 2; ++pass_) {
                bool have = false; int slot = 0;
                for (;;) {
                    const Frame F = mkframe(B);
                    gu32* qctr = (gu32*)(F.ws + WS_CTL) + CW_QUEUE + 64 * (j + 2 * (1 - pass_));
                    if (!have) { if (F.tid == 0) tk[slot] = __hip_atomic_fetch_add(qctr, 1u, RLX_AGENT); __syncthreads(); }
                    const int n = (int)tk[slot];
                    if (n >= NB * NH * 32 + DECB * NH) break;
                    const int grp = n / 5, rem = n - 5 * grp;
                    if (rem < 4) {
                        const int pu = 4 * grp + rem;
                        const int hh = 15 - (pu >> 7), r = pu & 127, qb = 31 - (r >> 2), b = r & 3, bh = b * NH + hh;
                        const float* Gbh = F.GT + (size_t)bh * SEQ;
                        const attn_body::bf16* Qb = (const attn_body::bf16*)F.R; const attn_body::bf16* Kb = Qb + (size_t)M * D; const attn_body::bf16* Vb = Kb + (size_t)M * D;
                        attn_body::attn_unit<16>(b, hh, qb, Qb, Kb, Vb, pass_ ? (attn_body::bf16*)F.R : (attn_body::bf16*)zbk(F, kin + 1), Gbh, (char*)lds + RING_OFF, F.tid, FOX_SKIP, (unsigned*)qctr, tk + (slot ^ 1));
                        have = true;
                    } else { if (pass_) sample_attn_item(F, j, grp >> 4, grp & 15); have = false; }
                    slot ^= 1;
                }
                }
                SEAM();
            }
            if (IN(pb + 5)) { RUN(4) { { const Frame F = mkframe(B); ps_oproj(F, i, 0); } { const Frame F = mkframe(B); ph_oproj(F, i); } { const Frame F = mkframe(B); ps_oproj(F, i, 1); } } SEAM(); }
        } else {
            if (IN(pb + 3)) { RUN(6) { { const Frame F = mkframe(B); pool_own(F, i >> 1, 4 * i + 1); } { const Frame F = mkframe(B); ps_poolgemm(F, i, 0); } { const Frame F = mkframe(B); ph_poolgemm(F, i); } { const Frame F = mkframe(B); ps_poolgemm(F, i, 1); } } SEAM(); }
        }
        if (IN(pb + 6)) { if (PROBE_DUP == 11) { const Frame F = mkframe(B); ph_ffn_in(F, i, 1, F.G > 0); } RUN(1) { { const Frame F = mkframe(B); ps_ffn_in(F, i, 1, 0); } { const Frame F = mkframe(B); ph_ffn_in(F, i, 1); } { const Frame F = mkframe(B); ps_ffn_in(F, i, 1, 1); } } SEAM(); }
        if (IN(pb + 7)) { if (PROBE_DUP == 12) { const Frame F = mkframe(B); ph_ffn_out(F, i, 1, F.G > 0); } RUN(2) { { const Frame F = mkframe(B); ps_ffn_out(F, i, 1, 0); } { const Frame F = mkframe(B); ph_ffn_out(F, i, 1); } { const Frame F = mkframe(B); ps_ffn_out(F, i, 1, 1); } } SEAM(); }
        if (IN(pb + 8)) { RUN(7) { { const Frame F = mkframe(B); ps_ple_a(F, i, 0); } { const Frame F = mkframe(B); ps_ple_b(F, i, 0); } { const Frame F = mkframe(B); ph_ple_a(F, i); } { const Frame F = mkframe(B); ph_ple_b(F, i); } { const Frame F = mkframe(B); ps_ple_a(F, i, 1); } { const Frame F = mkframe(B); ps_ple_b(F, i, 1); } } SEAM(); }
    }
    if (IN(41)) RUN(10) {
        const Frame F = mkframe(B);
        const int gw = F.vcu * NWAVES + F.wave, NGW = F.G * NWAVES;
        for (int m = gw; m < M; m += 2 * NGW) {
            const int m2 = m + NGW; const bool two = m2 < M;
            float mu1, rs1, mu2 = 0.f, rs2 = 1.f; row_stats_full(stk(F, 16), m, mu1, rs1); if (two) row_stats_full(stk(F, 16), m2, mu2, rs2);
            const GAS v2u* z1 = (const GAS v2u*)(zbk(F, 16) + (size_t)m * D) + F.lane; const GAS v2u* z2 = (const GAS v2u*)(zbk(F, 16) + (size_t)(two ? m2 : m) * D) + F.lane;
            const GAS f32x4* gi = (const GAS f32x4*)ln_gk(F, 16) + F.lane; const GAS f32x4* bi = (const GAS f32x4*)ln_bk(F, 16) + F.lane;
            v2u w1[4], w2[4];
#pragma unroll
            for (int j = 0; j < 4; ++j) { w1[j] = z1[64 * j]; w2[j] = z2[64 * j]; }
#pragma unroll
            for (int j = 0; j < 4; ++j) { const f32x4 g_ = gi[64 * j], b_ = bi[64 * j];
                const f32x2g l1 = upz<ZBF_E>(w1[j].x), h1 = upz<ZBF_E>(w1[j].y), l2 = upz<ZBF_E>(w2[j].x), h2 = upz<ZBF_E>(w2[j].y); const f32x4 a1 = {l1.x, l1.y, h1.x, h1.y}, a2 = {l2.x, l2.y, h2.x, h2.y};
                __builtin_nontemporal_store((a1 - mu1) * rs1 * g_ + b_, (f32x4*)((GAS f32x4*)(F.out + (size_t)m * D) + F.lane + 64 * j));
                if (two) __builtin_nontemporal_store((a2 - mu2) * rs2 * g_ + b_, (f32x4*)((GAS f32x4*)(F.out + (size_t)m2 * D) + F.lane + 64 * j)); }
        }
    }
#undef IN
#undef SEAM
#undef RUN
}

extern "C" void kernel_launch(void* const* d_in, const int* in_sizes, int n_in, void* d_out, int out_size, void* d_ws, size_t ws_size, hipStream_t stream) {
    static int grid = 0;
    if (grid == 0) {
        if (n_in != 20 || in_sizes[0] != MP * D || (size_t)out_size != O_END || ws_size < WS_END) {
            fprintf(stderr, "kernel_launch: unexpected shapes: n_in %d in0 %d out %d ws %zu (need %zu); nothing launched\n", n_in, n_in > 0 ? in_sizes[0] : -1, out_size, ws_size, (size_t)WS_END); grid = -1; return; }
        int dev = 0, cus = 0, per_cu = 0;
        if (hipGetDevice(&dev) != hipSuccess || hipDeviceGetAttribute(&cus, hipDeviceAttributeMultiprocessorCount, dev) != hipSuccess) { grid = -1; return; }
        if (hipFuncSetAttribute((const void*)fwd_kernel, hipFuncAttributeMaxDynamicSharedMemorySize, LDS_BYTES) != hipSuccess) { fprintf(stderr, "kernel_launch: hipFuncSetAttribute failed\n"); grid = -1; return; }
        if (hipOccupancyMaxActiveBlocksPerMultiprocessor(&per_cu, (const void*)fwd_kernel, NWAVES * 64, LDS_BYTES) != hipSuccess || per_cu < 1) { fprintf(stderr, "kernel_launch: occupancy query reports %d blocks per CU\n", per_cu); }
        (void)hipGetLastError();
        grid = cus;
        if (grid != 256) fprintf(stderr, "kernel_launch: %d CUs (expected 256)\n", grid);
    }
    if (grid < 0) return;
    (void)hipMemsetAsync((char*)d_ws + WS_CTL, 0, CTL_ZERO_BYTES, stream);
    Args a{};
    for (int i = 0; i < 20; ++i) a.in[i] = (const float*)d_in[i];
    a.out = (float*)d_out; a.ws = (unsigned char*)d_ws;
#if MK_PER_PHASE
    for (int p = 0; p < 42; ++p) { a.ph_lo = p; a.ph_hi = p + 1; hipLaunchKernelGGL(fwd_kernel, dim3(grid), dim3(NWAVES * 64), LDS_BYTES, stream, a); }
#else
    a.ph_lo = 0; a.ph_hi = 42;
    hipLaunchKernelGGL(fwd_kernel, dim3(grid), dim3(NWAVES * 64), LDS_BYTES, stream, a);
#endif
    const hipError_t le = hipPeekAtLastError();
    if (le != hipSuccess) fprintf(stderr, "kernel_launch: launch failed: %s\n", hipGetErrorName(le));
}
```

```cpp
#include <hip/hip_runtime.h>
#include <hip/hip_bf16.h>
#include <cstdio>
#include <cstdint>
#include <cmath>

constexpr int D = 1024, NB = 4, SEQ = 8192, DEPTH = 4, DECB = 32, DECS = 16, PAST = 1024, NH = 16, HD = 64, DFF = 2816, PLE = 256;
constexpr int MP = NB * SEQ;
constexpr int MS = DECB * DECS;
constexpr int M = MP + MS;
constexpr float LN_EPS = 1e-5f;
constexpr float ALPHA = 1.6817928305074292f;
constexpr float LOG2E = 1.4426950408889634f;
constexpr float C2 = 0.125f * 1.4426950408889634f;

__device__ __forceinline__ float xadd16(float x) { auto r = __builtin_amdgcn_permlane16_swap(__float_as_uint(x), __float_as_uint(x), false, false); return __uint_as_float(r[0]) + __uint_as_float(r[1]); }
__device__ __forceinline__ float xadd32(float x) { auto r = __builtin_amdgcn_permlane32_swap(__float_as_uint(x), __float_as_uint(x), false, false); return __uint_as_float(r[0]) + __uint_as_float(r[1]); }
__device__ __forceinline__ float xmax16(float x) { auto r = __builtin_amdgcn_permlane16_swap(__float_as_uint(x), __float_as_uint(x), false, false); return fmaxf(__uint_as_float(r[0]), __uint_as_float(r[1])); }
__device__ __forceinline__ float xmax32(float x) { auto r = __builtin_amdgcn_permlane32_swap(__float_as_uint(x), __float_as_uint(x), false, false); return fmaxf(__uint_as_float(r[0]), __uint_as_float(r[1])); }
__device__ __forceinline__ float bperm(float v, int src_lane) { return __uint_as_float((unsigned)__builtin_amdgcn_ds_bpermute(src_lane << 2, (int)__float_as_uint(v))); }

typedef _Float16 h16x2 __attribute__((ext_vector_type(2)));
typedef _Float16 h16x8 __attribute__((ext_vector_type(8)));
#ifndef Z_MODE
#define Z_MODE 1
#endif
constexpr bool ZBF_E = (Z_MODE >= 1), ZBF_O = (Z_MODE >= 2);
typedef float f32x2g __attribute__((ext_vector_type(2)));
typedef __bf16 b16x2g __attribute__((ext_vector_type(2)));
template <bool BF> __device__ __forceinline__ unsigned pkz(float lo, float hi) { const f32x2g v = {lo, hi}; if (BF) return __builtin_bit_cast(unsigned, __builtin_convertvector(v, b16x2g)); else return __builtin_bit_cast(unsigned, __builtin_convertvector(v, h16x2)); }
template <bool BF> __device__ __forceinline__ f32x2g upz(unsigned w) { if (BF) return (f32x2g){__uint_as_float(w << 16), __uint_as_float(w & 0xffff0000u)}; else return __builtin_convertvector(__builtin_bit_cast(h16x2, w), f32x2g); }

namespace pg8 {
#define PG8_LAS __attribute__((address_space(3)))
typedef unsigned short bf16_t;
typedef short bf16x8 __attribute__((ext_vector_type(8)));
typedef float f32x4 __attribute__((ext_vector_type(4)));
typedef float f32x2 __attribute__((ext_vector_type(2)));
typedef unsigned u32x4 __attribute__((ext_vector_type(4)));
constexpr int BM = 256, BK = 64, HALF = 128, HTB = HALF * BK * 2, STAGE_BYTES = 8 * HTB, NXCD = 8, WGM = 8;

__host__ __device__ __forceinline__ int lds_byte(int r, int c) { const int st = (r >> 4) * 2 + (c >> 5), rr = r & 15, cc = c & 31, ob = rr * 64 + cc * 2; return st * 1024 + (ob ^ (((ob >> 9) & 1) << 5)); }
__host__ __device__ __forceinline__ void stage_rc(int b, int& R, int& C) { const int st = b / 1024, sb = b % 1024, swz = sb ^ (((sb >> 9) & 1) << 5); R = (st >> 1) * 16 + swz / 64; C = (st & 1) * 32 + (swz % 64) / 2; }
__host__ __device__ __forceinline__ int perm32(int rho) { const int n = rho >> 4, i = rho & 15; return 8 * (i >> 2) + 4 * n + (i & 3); }

struct Unit { int pm, pn, slot; };
struct Gemm { const bf16_t* A; const bf16_t* Bt; int M, N, K, lda, apn; };

struct StaticOrder {
    int nM, nN, nwg, G, c;
    __host__ __device__ void init(int M_, int N_, int G_, int c_) { nM = M_ / BM; nN = N_ / BM; nwg = nM * nN; G = G_; c = c_; }
    __host__ __device__ bool next(int i, Unit& u) const {
        const long L = (long)i * G + c; if (L >= nwg) return false;
        int wgid = (int)L; { const int q = nwg / NXCD, r = nwg % NXCD, xcd = wgid % NXCD, off = wgid / NXCD; wgid = (xcd < r ? xcd * (q + 1) : r * (q + 1) + (xcd - r) * q) + off; }
        const int nig = WGM * nN, gid = wgid / nig, fm = gid * WGM, gsz = (nM - fm) < WGM ? (nM - fm) : WGM;
        u.pm = fm + ((wgid % nig) % gsz); u.pn = (wgid % nig) / gsz; return true;
    }
    __device__ __forceinline__ void a_ready(const Unit&) const {}
    __device__ __forceinline__ void done(const Unit&) const {}
    __device__ __forceinline__ int first_same_pm(int ui, int pm) const { Unit t; for (int k = 0; k < ui; ++k) { next(k, t); if (t.pm == pm) return k; } return ui; }
};

typedef __bf16 bf16x2n __attribute__((ext_vector_type(2)));
__device__ __forceinline__ unsigned cvt_pk_bf16(float lo, float hi) { const f32x2 v = {lo, hi}; return __builtin_bit_cast(unsigned, __builtin_convertvector(v, bf16x2n)); }
__device__ __forceinline__ u32x4 pack8(const f32x4 a, const f32x4 b) { u32x4 w; w.x = cvt_pk_bf16(a[0], a[1]); w.y = cvt_pk_bf16(a[2], a[3]); w.z = cvt_pk_bf16(b[0], b[1]); w.w = cvt_pk_bf16(b[2], b[3]); return w; }
__device__ __forceinline__ f32x4 bf_lo4(const u32x4 w) { f32x4 r; r[0] = __uint_as_float(w.x << 16); r[1] = __uint_as_float(w.x & 0xffff0000u); r[2] = __uint_as_float(w.y << 16); r[3] = __uint_as_float(w.y & 0xffff0000u); return r; }
__device__ __forceinline__ f32x4 bf_hi4(const u32x4 w) { f32x4 r; r[0] = __uint_as_float(w.z << 16); r[1] = __uint_as_float(w.z & 0xffff0000u); r[2] = __uint_as_float(w.w << 16); r[3] = __uint_as_float(w.w & 0xffff0000u); return r; }

typedef PG8_LAS const f32x2* StatTab;

#ifndef EPI_PRE_SWIGLU
#define EPI_PRE_SWIGLU 1
#endif
struct EpiSwiglu {
    static constexpr bool PERM = true, AFTER_DRAIN = false;
    bf16_t* H; StatTab T; const float* gW; const float* bW; int dry;
    static constexpr bool HAS_PRE = EPI_PRE_SWIGLU;
    PG8_LAS float* V;
    __device__ __forceinline__ float prefetch(const Unit& u, int tid) const { return ((tid & 256) ? bW : gW)[u.pn * BM + (tid & 255)]; }
    __device__ __forceinline__ void commit(float v, int ui, int tid) const { V[(ui & 1) * 512 + tid] = v; }
    __device__ __forceinline__ void operator()(const f32x4 (&acc)[2][2][4][2], const Unit& u, int wr, int wc, int fr, int fq, int ui = 0) const {
        if (dry) return;
        const int hc0 = wc * 32 + 8 * fq, nrow = u.pn * BM + hc0;
        f32x2 ga[4], ba[4], gu[4], bu[4];
        if constexpr (HAS_PRE) { const PG8_LAS float* v = V + (ui & 1) * 512 + hc0;
#pragma unroll
            for (int p = 0; p < 4; ++p) { ga[p] = *(const PG8_LAS f32x2*)(v + 2 * p); ba[p] = *(const PG8_LAS f32x2*)(v + 256 + 2 * p); gu[p] = *(const PG8_LAS f32x2*)(v + 128 + 2 * p); bu[p] = *(const PG8_LAS f32x2*)(v + 384 + 2 * p); }
        } else {
#pragma unroll
        for (int p = 0; p < 4; ++p) { ga[p] = *(const f32x2*)(gW + nrow + 2 * p); ba[p] = *(const f32x2*)(bW + nrow + 2 * p); gu[p] = *(const f32x2*)(gW + nrow + 128 + 2 * p); bu[p] = *(const f32x2*)(bW + nrow + 128 + 2 * p); }
        }
#pragma unroll
        for (int ai = 0; ai < 2; ++ai)
#pragma unroll
            for (int m = 0; m < 4; ++m) {
                const int lrow = ai * HALF + wr * 64 + m * 16 + fr, row = u.pm * BM + lrow;
                const f32x2 mr_ = T[u.slot * BM + lrow]; const float rs = mr_[1], nmr = -mr_[0] * rs;
                f32x2 A[4], U[4], d[4];
#pragma unroll
                for (int p = 0; p < 4; ++p) {
                    const f32x4 ra = acc[ai][0][m][p >> 1], ru = acc[ai][1][m][p >> 1];
                    const f32x2 xa = (p & 1) ? (f32x2){ra[2], ra[3]} : (f32x2){ra[0], ra[1]}, xu = (p & 1) ? (f32x2){ru[2], ru[3]} : (f32x2){ru[0], ru[1]};
                    A[p] = xa * rs + (ga[p] * nmr + ba[p]); U[p] = xu * rs + (gu[p] * nmr + bu[p]); }
#pragma unroll
                for (int p = 0; p < 4; ++p) d[p] = A[p] * (-LOG2E);
#pragma unroll
                for (int p = 0; p < 4; ++p) { d[p].x = __builtin_amdgcn_exp2f(d[p].x); d[p].y = __builtin_amdgcn_exp2f(d[p].y); }
#pragma unroll
                for (int p = 0; p < 4; ++p) { d[p] = d[p] + 1.0f; U[p] = U[p] * A[p]; }
#pragma unroll
                for (int p = 0; p < 4; ++p) { d[p].x = __builtin_amdgcn_rcpf(d[p].x); d[p].y = __builtin_amdgcn_rcpf(d[p].y); }
                unsigned w[4];
#pragma unroll
                for (int p = 0; p < 4; ++p) { const f32x2 h = U[p] * d[p]; w[p] = cvt_pk_bf16(h.x, h.y); }
                __builtin_nontemporal_store((u32x4){w[0], w[1], w[2], w[3]}, (u32x4*)(H + ((unsigned)row * DFF + u.pn * HALF + hc0)));
            }
    }
};

struct EpiQKV {
    static constexpr bool PERM = true, AFTER_DRAIN = false;
    static constexpr bool HAS_PRE = false;
    bf16_t* Q; float *kp, *ks; StatTab T; const float* gW; const float* bW;
    __device__ __forceinline__ void operator()(const f32x4 (&acc)[2][2][4][2], const Unit& u, int wr, int wc, int fr, int fq) const {
        const int colt = u.pn * BM, t = colt >> 10, nrow = colt + wc * 32 + 8 * fq, cb = (colt & 1023) + wc * 32 + 8 * fq;
        f32x4 g[2][2], b[2][2];
#pragma unroll
        for (int bj = 0; bj < 2; ++bj)
#pragma unroll
            for (int n = 0; n < 2; ++n) { g[bj][n] = *(const f32x4*)(gW + nrow + bj * HALF + 4 * n); b[bj][n] = *(const f32x4*)(bW + nrow + bj * HALF + 4 * n); }
        bf16_t* ob = Q + (size_t)t * ((size_t)M * D);
        const bool samp = (u.pm >= MP / BM);
        float* of = (samp ? ks : kp) + (t == 2 ? (samp ? 2ull * MS * D : 2ull * MP * D) : 0ull);
        const float sc = (t == 0) ? C2 : 1.0f;
#pragma unroll
        for (int ai = 0; ai < 2; ++ai)
#pragma unroll
            for (int m = 0; m < 4; ++m) {
                const int lrow = ai * HALF + wr * 64 + m * 16 + fr, row = u.pm * BM + lrow;
                const f32x2 mr_ = T[u.slot * BM + lrow]; const float rs = mr_[1], mr = mr_[0] * rs;
                const int orow = samp ? row - MP : row;
#pragma unroll
                for (int bj = 0; bj < 2; ++bj) {
                    const f32x4 v0 = acc[ai][bj][m][0] * rs + (b[bj][0] - mr * g[bj][0]), v1 = acc[ai][bj][m][1] * rs + (b[bj][1] - mr * g[bj][1]);
                    *(u32x4*)(ob + ((unsigned)row * D + cb + bj * HALF)) = pack8(v0 * sc, v1 * sc);
                    if (t != 0) { float* o = of + ((unsigned)orow * D + cb + bj * HALF); __builtin_nontemporal_store(v0, (f32x4*)o); __builtin_nontemporal_store(v1, (f32x4*)(o + 4)); }
                }
            }
    }
};

struct EpiStoreBf16 {
    static constexpr bool PERM = true, AFTER_DRAIN = false;
    static constexpr bool HAS_PRE = false;
    bf16_t* O;
    __device__ __forceinline__ void operator()(const f32x4 (&acc)[2][2][4][2], const Unit& u, int wr, int wc, int fr, int fq) const {
        const int col = u.pn * BM + wc * 32 + 8 * fq;
#pragma unroll
        for (int ai = 0; ai < 2; ++ai)
#pragma unroll
            for (int m = 0; m < 4; ++m) {
                const int row = u.pm * BM + ai * HALF + wr * 64 + m * 16 + fr;
#pragma unroll
                for (int bj = 0; bj < 2; ++bj) *(u32x4*)(O + ((unsigned)row * D + col + bj * HALF)) = pack8(acc[ai][bj][m][0], acc[ai][bj][m][1]);
            }
    }
};

template <int MODE, bool INBF, bool OUTBF> struct EpiRes {
    static constexpr bool PERM = true, AFTER_DRAIN = false;
    static constexpr bool HAS_PRE = false;
    const bf16_t* zp; bf16_t* zb; float* st_out; StatTab T; const float* gp; const float* bp;
    float cs; const float* vec; const float* gW; const float* cW; const bf16_t* pp; int dry;
    static constexpr int GS = (MODE == 2) ? 2 : 4;
    static __device__ __forceinline__ unsigned loff(int L) { return (unsigned)((L >> 3) * HALF + ((L >> 2) & 1) * HALF * D + (L & 3) * 16 * D); }
    __device__ __forceinline__ void operator()(const f32x4 (&acc)[2][2][4][2], const Unit& u, int wr, int wc, int fr, int fq) const {
        if (dry) return;
        const int lrow0 = wr * 64 + fr;
        const unsigned offb = (unsigned)(u.pm * BM + lrow0) * D + u.pn * BM + wc * 32 + 8 * fq;
        u32x4 zbuf[2][GS], pbuf[2][GS];
#pragma unroll
        for (int k = 0; k < GS; ++k) { zbuf[0][k] = *(const u32x4*)(zp + offb + loff(k)); if (MODE == 2) pbuf[0][k] = *(const u32x4*)(pp + offb + loff(k)); }
        f32x2 gA[4], bA[4], e_[4], f_[4];
#pragma unroll
        for (int st = 0; st < 16 / GS; ++st) {
            if (st + 1 < 16 / GS) {
#pragma unroll
                for (int k = 0; k < GS; ++k) { const unsigned o = offb + loff((st + 1) * GS + k); zbuf[(st + 1) & 1][k] = *(const u32x4*)(zp + o); if (MODE == 2) pbuf[(st + 1) & 1][k] = *(const u32x4*)(pp + o); }
            }
#pragma unroll
            for (int k = 0; k < GS; ++k) {
                const int L = st * GS + k, bj = L >> 3, ai = (L >> 2) & 1, m = L & 3;
                const int col = u.pn * BM + bj * HALF + wc * 32 + 8 * fq;
                if ((L & 7) == 0) {
#pragma unroll
                    for (int p = 0; p < 4; ++p) { gA[p] = *(const f32x2*)(gp + col + 2 * p) * ALPHA; bA[p] = *(const f32x2*)(bp + col + 2 * p) * ALPHA;
                        if (MODE == 1) e_[p] = *(const f32x2*)(vec + col + 2 * p);
                        if (MODE == 2) { e_[p] = *(const f32x2*)(gW + col + 2 * p); f_[p] = *(const f32x2*)(cW + col + 2 * p); } }
                }
                const int lrow = lrow0 + ai * HALF + m * 16, row = u.pm * BM + lrow; const unsigned off = (unsigned)row * D + col;
                const u32x4 zw = zbuf[st & 1][k], pw = pbuf[st & 1][k];
                const f32x2 mr_ = T[u.slot * BM + lrow]; const float r_ = mr_[1], nmr = -mr_[0] * r_;
                unsigned w[4]; f32x2 s2 = {0.f, 0.f}, q2 = {0.f, 0.f}, z[4], xa[4], d[4];
#pragma unroll
                for (int p = 0; p < 4; ++p) { const f32x4 ra = acc[ai][bj][m][p >> 1]; xa[p] = (p & 1) ? (f32x2){ra[2], ra[3]} : (f32x2){ra[0], ra[1]}; z[p] = upz<INBF>(zw[p]) * r_ + nmr; }
#pragma unroll
                for (int p = 0; p < 4; ++p) { z[p] = z[p] * gA[p] + bA[p]; if (MODE == 2) d[p] = (xa[p] * r_ + (e_[p] * nmr + f_[p])) * (-LOG2E); }
                if (MODE == 2) {
#pragma unroll
                    for (int p = 0; p < 4; ++p) { d[p].x = __builtin_amdgcn_exp2f(d[p].x); d[p].y = __builtin_amdgcn_exp2f(d[p].y); }
#pragma unroll
                    for (int p = 0; p < 4; ++p) d[p] = d[p] + 1.0f;
#pragma unroll
                    for (int p = 0; p < 4; ++p) { d[p].x = __builtin_amdgcn_rcpf(d[p].x); d[p].y = __builtin_amdgcn_rcpf(d[p].y); }
                }
#pragma unroll
                for (int p = 0; p < 4; ++p) {
                    if (MODE == 0) z[p] = xa[p] * cs + z[p];
                    else if (MODE == 1) z[p] = xa[p] * e_[p] + z[p];
                    else { const f32x2 pf = {__uint_as_float(pw[p] << 16), __uint_as_float(pw[p] & 0xffff0000u)}; z[p] = pf * d[p] + z[p]; }
                }
#pragma unroll
                for (int p = 0; p < 4; ++p) { w[p] = pkz<OUTBF>(z[p].x, z[p].y); s2 += z[p]; q2 = z[p] * z[p] + q2; }
                *(u32x4*)(zb + off) = (u32x4){w[0], w[1], w[2], w[3]};
                float s = s2.x + s2.y, q = q2.x + q2.y;
                s = xadd32(xadd16(s)); q = xadd32(xadd16(q));
                if (fq == 0) *(f32x2*)(st_out + (unsigned)row * 64 + (u.pn * 8 + bj * 4 + wc) * 2) = (f32x2){s, q};
            }
            asm volatile("" ::: "memory");
        }
    }
};

struct NoHook { static constexpr bool REAL = false; __device__ __forceinline__ void operator()() const {} };
template <class Epi, class Sched, bool ALIGN_EPI = false, bool SP2 = false, bool F16 = false, bool PEEL = false, class Hook = NoHook>
__device__ __forceinline__ void gemm_phase(PG8_LAS unsigned char* lds, const Gemm g, const Sched& S, const Epi& E, const int tid, const Hook& hook = Hook()) {
    const int wid = __builtin_amdgcn_readfirstlane(tid >> 6), lane = tid & 63, wr = wid >> 2, wc = wid & 3, fr = lane & 15, fq = lane >> 4;
    const int K = g.K, nt = K / BK;
    unsigned voffA[2], voffB[2];
#pragma unroll
    for (int i = 0; i < 2; ++i) { int R, C; stage_rc(tid * 16 + i * 8192, R, C); const int Rb = Epi::PERM ? ((R & ~31) + perm32(R & 31)) : R;
        voffA[i] = (unsigned)(R * g.lda + C) * 2u; voffB[i] = (unsigned)(Rb * K + C) * 2u; }
    const size_t kstep = (size_t)(BK * 2);
    const size_t hstepA = (size_t)HALF * g.lda * 2, hstepB = (size_t)HALF * K * 2;
    const size_t tstepA = 2 * hstepA, tstepB = 2 * hstepB;
    const unsigned ldsw = (unsigned)wid * 1024u;
    const int aoff = lds_byte(wr * 64 + fr, fq * 8), boff = lds_byte(wc * 32 + fr, fq * 8);
#define PG8_SA(b, h) (((b) * 2 + (h)) * HTB)
#define PG8_SB(b, h) ((4 + (b) * 2 + (h)) * HTB)
#define PG8_STAGE(bufoff, gbase, voff) do { _Pragma("unroll") for (int _i = 0; _i < 2; ++_i) \
        __builtin_amdgcn_global_load_lds((const unsigned*)((const char*)(gbase) + (voff)[_i]), (PG8_LAS unsigned*)(lds + (bufoff) + ldsw + _i * 8192), 16, 0, 0); } while (0)
#define PG8_LDA(dst, b, h) do { _Pragma("unroll") for (int m = 0; m < 4; ++m) _Pragma("unroll") for (int k = 0; k < 2; ++k) dst[m][k] = *(const PG8_LAS bf16x8*)(lds + PG8_SA(b, h) + aoff + m * 2048 + k * 1024); } while (0)
#define PG8_LDB(dst, b, h) do { _Pragma("unroll") for (int n = 0; n < 2; ++n) _Pragma("unroll") for (int k = 0; k < 2; ++k) dst[n][k] = *(const PG8_LAS bf16x8*)(lds + PG8_SB(b, h) + boff + n * 2048 + k * 1024); } while (0)
#define PG8_MMA(ai, bj, At, Bt) do { __builtin_amdgcn_s_setprio(1); _Pragma("unroll") for (int m = 0; m < 4; ++m) _Pragma("unroll") for (int n = 0; n < 2; ++n) _Pragma("unroll") for (int k = 0; k < 2; ++k) \
        acc[ai][bj][m][n] = F16 ? __builtin_amdgcn_mfma_f32_16x16x32_f16(__builtin_bit_cast(h16x8, Bt[n][k]), __builtin_bit_cast(h16x8, At[m][k]), acc[ai][bj][m][n], 0, 0, 0) \
                                : __builtin_amdgcn_mfma_f32_16x16x32_bf16(Bt[n][k], At[m][k], acc[ai][bj][m][n], 0, 0, 0); __builtin_amdgcn_s_setprio(0); } while (0)
#define PG8_MMA0(ai, bj, At, Bt) do { __builtin_amdgcn_s_setprio(1); _Pragma("unroll") for (int m = 0; m < 4; ++m) _Pragma("unroll") for (int n = 0; n < 2; ++n) { \
        acc[ai][bj][m][n] = F16 ? __builtin_amdgcn_mfma_f32_16x16x32_f16(__builtin_bit_cast(h16x8, Bt[n][0]), __builtin_bit_cast(h16x8, At[m][0]), (f32x4){0.f, 0.f, 0.f, 0.f}, 0, 0, 0) \
                                : __builtin_amdgcn_mfma_f32_16x16x32_bf16(Bt[n][0], At[m][0], (f32x4){0.f, 0.f, 0.f, 0.f}, 0, 0, 0); \
        asm("" : "+v"(acc[ai][bj][m][n])); \
        acc[ai][bj][m][n] = F16 ? __builtin_amdgcn_mfma_f32_16x16x32_f16(__builtin_bit_cast(h16x8, Bt[n][1]), __builtin_bit_cast(h16x8, At[m][1]), acc[ai][bj][m][n], 0, 0, 0) \
                                : __builtin_amdgcn_mfma_f32_16x16x32_bf16(Bt[n][1], At[m][1], acc[ai][bj][m][n], 0, 0, 0); } __builtin_amdgcn_s_setprio(0); } while (0)
#define PG8_WAIT_V(n) asm volatile("s_waitcnt vmcnt(" #n ")" ::: "memory")
#define PG8_WAIT_L(n) asm volatile("s_waitcnt lgkmcnt(" #n ")" ::: "memory")
#define PG8_BAR __builtin_amdgcn_s_barrier()
#define PG8_SCHED __builtin_amdgcn_sched_barrier(0)
    Unit cur, nxt; int ui = 0;
    if (!S.next(0, cur)) return;
    cur.slot = 0;
    float pre = 0.f;
    if constexpr (Epi::HAS_PRE) pre = E.prefetch(cur, ({ int ln_; asm volatile("v_mbcnt_lo_u32_b32 %0, -1, 0\n\tv_mbcnt_hi_u32_b32 %0, -1, %0" : "=v"(ln_)); wid * 64 + ln_; }));
    f32x4 acc[2][2][4][2];
    if constexpr (!(SP2 && PEEL)) {
#pragma unroll
    for (int a = 0; a < 2; ++a)
#pragma unroll
        for (int b = 0; b < 2; ++b)
#pragma unroll
            for (int m = 0; m < 4; ++m)
#pragma unroll
                for (int n = 0; n < 2; ++n) acc[a][b][m][n] = (f32x4){0.f, 0.f, 0.f, 0.f};
    }
    bf16x8 At[4][2], B0[2][2], B1[2][2];
    const char* cA = (const char*)g.A + (size_t)cur.pm * tstepA + (size_t)cur.pn * (size_t)g.apn; const char* cB = (const char*)g.Bt + (size_t)cur.pn * tstepB;
    S.a_ready(cur);
    if constexpr (SP2) {
        PG8_STAGE(PG8_SB(0, 0), cB, voffB); PG8_STAGE(PG8_SB(0, 1), cB + hstepB, voffB); PG8_STAGE(PG8_SA(0, 0), cA, voffA); PG8_STAGE(PG8_SA(0, 1), cA + hstepA, voffA);
        if constexpr (Hook::REAL) {
            PG8_STAGE(PG8_SB(1, 0), cB + kstep, voffB); PG8_STAGE(PG8_SA(1, 0), cA + kstep, voffA); PG8_STAGE(PG8_SB(1, 1), cB + hstepB + kstep, voffB);
            hook();
            if (wr == 1) PG8_BAR;
            PG8_WAIT_V(6); PG8_BAR;
        } else {
        if (wr == 1) PG8_BAR;
        PG8_WAIT_V(2); PG8_BAR;
        PG8_STAGE(PG8_SB(1, 0), cB + kstep, voffB); PG8_STAGE(PG8_SA(1, 0), cA + kstep, voffA); PG8_STAGE(PG8_SB(1, 1), cB + hstepB + kstep, voffB);
        PG8_WAIT_V(6); PG8_BAR;
        }
    } else {
        PG8_STAGE(PG8_SB(0, 0), cB, voffB); PG8_STAGE(PG8_SA(0, 0), cA, voffA); PG8_STAGE(PG8_SB(0, 1), cB + hstepB, voffB); PG8_STAGE(PG8_SA(0, 1), cA + hstepA, voffA);
        if (wr == 1) PG8_BAR;
        PG8_WAIT_V(4); PG8_BAR;
        PG8_STAGE(PG8_SB(1, 0), cB + kstep, voffB); PG8_STAGE(PG8_SA(1, 0), cA + kstep, voffA); PG8_STAGE(PG8_SB(1, 1), cB + hstepB + kstep, voffB);
        PG8_WAIT_V(6); PG8_BAR;
    }
    for (;;) {
        const bool has_next = S.next(ui + 1, nxt);
        const char* nA = has_next ? (const char*)g.A + (size_t)nxt.pm * tstepA + (size_t)nxt.pn * (size_t)g.apn : cA; const char* nB = has_next ? (const char*)g.Bt + (size_t)nxt.pn * tstepB : cB;
#define PG8_PTRS(t) const bool last = ((t) == nt - 2); \
            const char* a1 = cA + (size_t)((t) + 1) * kstep; \
            const char* a2 = last ? nA : cA + (size_t)((t) + 2) * kstep; const char* b2 = last ? nB : cB + (size_t)((t) + 2) * kstep; \
            const char* a3 = a2 + kstep; const char* b3 = b2 + kstep; \
            if (last && has_next) S.a_ready(nxt);
#define PG8_BODY_SP2(MMF) \
            PG8_LDB(B0, 0, 0); PG8_LDB(B1, 0, 1); PG8_SCHED; PG8_LDA(At, 0, 0); PG8_STAGE(PG8_SA(1, 1), a1 + hstepA, voffA); \
            PG8_WAIT_V(8); PG8_WAIT_L(0); PG8_BAR; MMF(0, 0, At, B0); MMF(0, 1, At, B1); PG8_BAR; PG8_SCHED; \
            PG8_LDA(At, 0, 1); PG8_STAGE(PG8_SB(0, 0), b2, voffB); PG8_STAGE(PG8_SB(0, 1), b2 + hstepB, voffB); PG8_STAGE(PG8_SA(0, 0), a2, voffA); \
            PG8_WAIT_V(8); PG8_WAIT_L(0); PG8_BAR; MMF(1, 0, At, B0); MMF(1, 1, At, B1); PG8_BAR; PG8_SCHED; \
            PG8_LDB(B0, 1, 0); PG8_LDB(B1, 1, 1); PG8_SCHED; PG8_LDA(At, 1, 0); PG8_STAGE(PG8_SA(0, 1), a2 + hstepA, voffA); \
            PG8_WAIT_V(8); PG8_WAIT_L(0); PG8_BAR; PG8_MMA(0, 0, At, B0); PG8_MMA(0, 1, At, B1); PG8_BAR; PG8_SCHED; \
            PG8_LDA(At, 1, 1); PG8_STAGE(PG8_SB(1, 0), b3, voffB); PG8_STAGE(PG8_SB(1, 1), b3 + hstepB, voffB); PG8_STAGE(PG8_SA(1, 0), a3, voffA); \
            PG8_WAIT_V(8); PG8_WAIT_L(0); PG8_BAR; PG8_MMA(1, 0, At, B0); PG8_MMA(1, 1, At, B1); PG8_BAR; PG8_SCHED;
        if constexpr (SP2 && PEEL) {
            { PG8_PTRS(0) PG8_BODY_SP2(PG8_MMA0) }
            if constexpr (Epi::HAS_PRE) E.commit(pre, ui, ({ int ln_; asm volatile("v_mbcnt_lo_u32_b32 %0, -1, 0\n\tv_mbcnt_hi_u32_b32 %0, -1, %0" : "=v"(ln_)); wid * 64 + ln_; }));
            for (int t = 2; t < nt; t += 2) { PG8_PTRS(t) PG8_BODY_SP2(PG8_MMA) }
        } else if constexpr (SP2) {
            for (int t = 0; t < nt; t += 2) { PG8_PTRS(t) PG8_BODY_SP2(PG8_MMA) }
        } else {
        for (int t = 0; t < nt; t += 2) {
            PG8_PTRS(t)
            PG8_LDB(B0, 0, 0); PG8_SCHED; PG8_LDA(At, 0, 0); PG8_STAGE(PG8_SA(1, 1), a1 + hstepA, voffA);
            PG8_WAIT_L(8); PG8_BAR; PG8_WAIT_L(0); PG8_MMA(0, 0, At, B0); PG8_BAR; PG8_SCHED;
            PG8_LDB(B1, 0, 1); PG8_STAGE(PG8_SB(0, 0), b2, voffB);
            PG8_BAR; PG8_WAIT_L(0); PG8_MMA(0, 1, At, B1); PG8_BAR;
            PG8_LDA(At, 0, 1); PG8_STAGE(PG8_SA(0, 0), a2, voffA);
            PG8_BAR; PG8_WAIT_L(0); PG8_MMA(1, 0, At, B0); PG8_BAR; PG8_SCHED;
            PG8_STAGE(PG8_SB(0, 1), b2 + hstepB, voffB);
            PG8_WAIT_V(6); PG8_BAR; PG8_MMA(1, 1, At, B1); PG8_BAR;
            PG8_LDB(B0, 1, 0); PG8_SCHED; PG8_LDA(At, 1, 0); PG8_STAGE(PG8_SA(0, 1), a2 + hstepA, voffA);
            PG8_WAIT_L(8); PG8_BAR; PG8_WAIT_L(0); PG8_MMA(0, 0, At, B0); PG8_BAR; PG8_SCHED;
            PG8_LDB(B1, 1, 1); PG8_STAGE(PG8_SB(1, 0), b3, voffB);
            PG8_BAR; PG8_WAIT_L(0); PG8_MMA(0, 1, At, B1); PG8_BAR;
            PG8_LDA(At, 1, 1); PG8_STAGE(PG8_SA(1, 0), a3, voffA);
            PG8_BAR; PG8_WAIT_L(0); PG8_MMA(1, 0, At, B0); PG8_BAR; PG8_SCHED;
            PG8_STAGE(PG8_SB(1, 1), b3 + hstepB, voffB);
            PG8_WAIT_V(6); PG8_BAR; PG8_MMA(1, 1, At, B1); PG8_BAR;
        }
        }
#undef PG8_PTRS
#undef PG8_BODY_SP2
        if constexpr (ALIGN_EPI) { if (wr == 0) PG8_BAR; }
        if constexpr (!Epi::AFTER_DRAIN) {
            int ln; asm volatile("v_mbcnt_lo_u32_b32 %0, -1, 0\n\tv_mbcnt_hi_u32_b32 %0, -1, %0" : "=v"(ln));
            if constexpr (Epi::HAS_PRE) E(acc, cur, wr, wc, ln & 15, ln >> 4, ui); else E(acc, cur, wr, wc, ln & 15, ln >> 4);
            S.done(cur); }
        if (!has_next) break;
        if constexpr (!(SP2 && PEEL)) {
#pragma unroll
        for (int a = 0; a < 2; ++a)
#pragma unroll
            for (int b = 0; b < 2; ++b)
#pragma unroll
                for (int m = 0; m < 4; ++m)
#pragma unroll
                    for (int n = 0; n < 2; ++n) acc[a][b][m][n] = (f32x4){0.f, 0.f, 0.f, 0.f};
        }
        { const int ppm = cur.pm, pslot = cur.slot; cur = nxt; cA = nA; cB = nB; ++ui; cur.slot = (cur.pm == ppm) ? pslot : S.first_same_pm(ui, cur.pm); }
        if constexpr (Epi::HAS_PRE) pre = E.prefetch(cur, ({ int ln_; asm volatile("v_mbcnt_lo_u32_b32 %0, -1, 0\n\tv_mbcnt_hi_u32_b32 %0, -1, %0" : "=v"(ln_)); wid * 64 + ln_; }));
        if constexpr (ALIGN_EPI) { if (wr == 1) PG8_BAR; }
    }
    PG8_WAIT_V(0);
    if constexpr (!ALIGN_EPI) { if (wr == 0) PG8_BAR; }
    PG8_BAR;
#undef PG8_SA
#undef PG8_SB
#undef PG8_STAGE
#undef PG8_LDA
#undef PG8_LDB
#undef PG8_MMA
#undef PG8_MMA0
#undef PG8_WAIT_V
#undef PG8_WAIT_L
#undef PG8_BAR
#undef PG8_SCHED
}
}

namespace attn_body {
using bf16=__hip_bfloat16;
using bf16x8=__attribute__((ext_vector_type(8)))short;
using s16x4=__attribute__((ext_vector_type(4)))short;
using f32x16=__attribute__((ext_vector_type(16)))float;
using f32x4a=__attribute__((ext_vector_type(4)))float;
using u32x4=__attribute__((ext_vector_type(4)))unsigned;
constexpr int NHEAD=16,SEQ=8192,D=64,DM=NHEAD*D;
constexpr int NW=8,QBLK=32,QB=QBLK*NW,KVBLK=64,NQB=SEQ/QB;
__device__ __forceinline__ int crow(int r,int hi){return (r&3)+8*(r>>2)+4*hi;}
#define SBAR() __builtin_amdgcn_sched_barrier(0)
__device__ __forceinline__ void cmask(f32x16&p0,f32x16&p1,int jb,int qrel,int hi){
  const float NEG=-INFINITY; int kb=64*jb+4*hi;
  #pragma unroll
  for(int r=0;r<16;++r){int kv=kb+(r&3)+8*(r>>2); if(kv>qrel)p0[r]=NEG; if(kv+32>qrel)p1[r]=NEG;}
}
constexpr int NSLOT=3, SLOTB=8192;
constexpr int LDS_K=0, LDS_V=NSLOT*SLOTB, LDS_WS=2*NSLOT*SLOTB, LDS_OST=LDS_WS+NW*64*4, LDS_G=LDS_OST+NW*4096, LDS_BYTES=LDS_G+SEQ*4;
__device__ __forceinline__ void glds16(const void*gsrc,unsigned lds_dst){unsigned keep;
  asm volatile("s_mov_b32 %0, m0\n\ts_mov_b32 m0, %2\n\ts_nop 0\n\tglobal_load_lds_dwordx4 %1, off\n\ts_mov_b32 m0, %0":"=&s"(keep):"v"(gsrc),"s"(lds_dst):"memory");}
__device__ __forceinline__ float max3f(float a,float b,float c){float r;asm("v_max3_f32 %0, %1, %2, %3":"=v"(r):"v"(a),"v"(b),"v"(c));return r;}
__device__ __forceinline__ float max2f(float a,float b){float r;asm("v_max_f32_e32 %0, %1, %2":"=v"(r):"v"(a),"v"(b));return r;}
__device__ __forceinline__ float fadd_s(float a,float b){float r;asm("v_add_f32_e32 %0, %1, %2":"=v"(r):"v"(a),"v"(b));return r;}
__device__ __forceinline__ float fsub_s(float a,float b){float r;asm("v_sub_f32_e32 %0, %1, %2":"=v"(r):"v"(a),"v"(b));return r;}
typedef float f32x2_t __attribute__((ext_vector_type(2))); typedef __bf16 bf16x2_t __attribute__((ext_vector_type(2)));
__device__ __forceinline__ unsigned cvtpk_s(float lo,float hi){f32x2_t v={lo,hi};bf16x2_t b=__builtin_convertvector(v,bf16x2_t);return __builtin_bit_cast(unsigned,b);}
#define WAIT_BAR(N) asm volatile("s_waitcnt vmcnt(" #N ") lgkmcnt(0)\n\ts_barrier":::"memory")

__device__ __forceinline__ void qkt(f32x16&p0,f32x16&p1,const char*Kslot,const bf16x8*qr,int r32,int hi){
  const char*kb=Kslot+hi*1024+r32*16;
  #pragma unroll
  for(int d0=0;d0<4;++d0){
    const bf16x8 b0=*reinterpret_cast<const bf16x8*>(kb+d0*2048);
    const bf16x8 b1=*reinterpret_cast<const bf16x8*>(kb+d0*2048+512);
    p0=__builtin_amdgcn_mfma_f32_32x32x16_bf16(b0,qr[d0],p0,0,0,0);p1=__builtin_amdgcn_mfma_f32_32x32x16_bf16(b1,qr[d0],p1,0,0,0);}
}
typedef __attribute__((address_space(3))) const char* lds_cptr;
typedef short v4i16_t __attribute__((ext_vector_type(4)));
__device__ __forceinline__ void kload8(bf16x8*kf,lds_cptr kp){
  kf[0]=*(const __attribute__((address_space(3))) bf16x8*)(kp);      kf[1]=*(const __attribute__((address_space(3))) bf16x8*)(kp+512);
  kf[2]=*(const __attribute__((address_space(3))) bf16x8*)(kp+2048); kf[3]=*(const __attribute__((address_space(3))) bf16x8*)(kp+2560);
  kf[4]=*(const __attribute__((address_space(3))) bf16x8*)(kp+4096); kf[5]=*(const __attribute__((address_space(3))) bf16x8*)(kp+4608);
  kf[6]=*(const __attribute__((address_space(3))) bf16x8*)(kp+6144); kf[7]=*(const __attribute__((address_space(3))) bf16x8*)(kp+6656);
}
__device__ __forceinline__ void kload2(bf16x8*kf,lds_cptr kp,int j){ kf[2*j]=*(const __attribute__((address_space(3))) bf16x8*)(kp+j*2048); kf[2*j+1]=*(const __attribute__((address_space(3))) bf16x8*)(kp+j*2048+512); }
__device__ __forceinline__ s16x4 vtr(lds_cptr p){ return __builtin_bit_cast(s16x4,__builtin_amdgcn_ds_read_tr16_b64_v4i16((__attribute__((address_space(3))) v4i16_t*)p)); }
__device__ __forceinline__ float rowmax(const f32x16&p0,const f32x16&p1){
  float a=max3f(p0[0],p0[1],p1[0]),b=max3f(p0[2],p0[3],p1[1]);a=max3f(a,p1[2],p1[3]);
  #pragma unroll
  for(int r=4;r<16;r+=4){a=max3f(a,p0[r],p0[r+1]);b=max3f(b,p0[r+2],p0[r+3]);a=max3f(a,p1[r],p1[r+1]);b=max3f(b,p1[r+2],p1[r+3]);}
  const float m=max2f(a,b);
  auto rr=__builtin_amdgcn_permlane32_swap(__float_as_uint(m),__float_as_uint(m),false,false);
  return max2f(__uint_as_float(rr[0]),__uint_as_float(rr[1]));
}
__device__ __forceinline__ void pv(f32x16*o,int vb,bf16x8 pa0,bf16x8 pa1,bf16x8 pa2,bf16x8 pa3){
  #pragma unroll
  for(int d0=0;d0<2;++d0){s16x4 lo[4],hi[4];
    #pragma unroll
    for(int ks=0;ks<4;++ks){
      asm volatile("ds_read_b64_tr_b16 %0,%1 offset:%c2":"=&v"(lo[ks]):"v"(vb),"i"(d0*4096+ks*1024):"memory");
      asm volatile("ds_read_b64_tr_b16 %0,%1 offset:%c2":"=&v"(hi[ks]):"v"(vb),"i"(d0*4096+ks*1024+512):"memory");}
    asm volatile("s_waitcnt lgkmcnt(0)":::"memory");SBAR();
    #define PK(k) (bf16x8){lo[k][0],lo[k][1],lo[k][2],lo[k][3],hi[k][0],hi[k][1],hi[k][2],hi[k][3]}
    o[d0]=__builtin_amdgcn_mfma_f32_32x32x16_bf16(pa0,PK(0),o[d0],0,0,0);
    o[d0]=__builtin_amdgcn_mfma_f32_32x32x16_bf16(pa1,PK(1),o[d0],0,0,0);
    o[d0]=__builtin_amdgcn_mfma_f32_32x32x16_bf16(pa2,PK(2),o[d0],0,0,0);
    o[d0]=__builtin_amdgcn_mfma_f32_32x32x16_bf16(pa3,PK(3),o[d0],0,0,0);
    #undef PK
  }
}
typedef __attribute__((address_space(3))) const f32x4a* lds_f4ptr;
__device__ __forceinline__ void pre(f32x16&p0,f32x16&p1,lds_cptr gl,int t,int hi,float c0){
  const lds_cptr gt=gl+(64*t+4*hi)*4;
  #pragma unroll
  for(int a=0;a<4;++a){ const f32x4a g0=*(lds_f4ptr)(gt+a*32), g1=*(lds_f4ptr)(gt+128+a*32);
    #pragma unroll
    for(int i=0;i<4;++i){p0[4*a+i]=c0-g0[i];p1[4*a+i]=c0-g1[i];} }
}
#ifndef ATTN_STORE16
#define ATTN_STORE16(p,v) (*(u32x4*)(p)=(v))
#endif
template<int THRL> __device__ __forceinline__ void attn_unit(int b,int h,int qb,const bf16*Q,const bf16*__restrict__ K,const bf16*__restrict__ V,bf16*O,const float*__restrict__ Gbh,char*shm,const int tid,const int t0in,unsigned*qctr,volatile __attribute__((address_space(3))) unsigned*tknext){
  const int lane=tid&63,r32=lane&31,hi=lane>>5; const int wid=__builtin_amdgcn_readfirstlane(tid>>6);
  const long rowbase=(long)b*SEQ; const int q0=qb*QB;
  const bf16*Qw=Q+(rowbase+q0+wid*QBLK)*DM+h*D;
  const unsigned lds0=(unsigned)(uintptr_t)shm;
  float*wsf=(float*)(shm+LDS_WS)+wid*64;
  const lds_cptr shm3=(lds_cptr)shm;
  __attribute__((address_space(3))) float* gw=(__attribute__((address_space(3))) float*)(shm3+LDS_G);
  unsigned nxt_=0u; if(qctr&&tid==0)nxt_=__hip_atomic_fetch_add(qctr,1u,__ATOMIC_RELAXED,__HIP_MEMORY_SCOPE_AGENT);
  const int t0=t0in;
  const bf16*Kh=K+(rowbase+(long)t0*KVBLK)*DM+h*D,*Vh=V+(rowbase+(long)t0*KVBLK)*DM+h*D;
  const lds_cptr gl=shm3+LDS_G+t0*KVBLK*4;
  const bf16*ksrc=Kh+(long)lane*DM+wid*8;
  const bf16*vsrc=Vh+(long)(16*(wid&3)+(lane>>2))*DM+(wid>>2)*32+(lane&3)*8;
  const unsigned kdst=lds0+LDS_K+wid*1024, vdst=lds0+LDS_V+wid*1024;
  #define DMA_K(t,slot) glds16(ksrc+(long)(t)*KVBLK*DM,(unsigned)__builtin_amdgcn_readfirstlane(kdst+(slot)))
  #define DMA_V(t,slot) glds16(vsrc+(long)(t)*KVBLK*DM,(unsigned)__builtin_amdgcn_readfirstlane(vdst+(slot)))
  const int vb0=(int)(lds0+LDS_V)+((lane>>4)&1)*32+(lane&3)*8+(4*hi+((lane&15)>>2))*64;
  const char*Kbase=shm+LDS_K; bf16x8 kf[8];
  const lds_cptr kp0=shm3+LDS_K+hi*1024+r32*16; const lds_cptr vp0=shm3+LDS_V+((lane>>4)&1)*32+(lane&3)*8+(4*hi+((lane&15)>>2))*64;
  const int NT=(q0+QB)/KVBLK-t0;
  DMA_K(0,0);DMA_V(0,0);DMA_K(1,SLOTB);
  for(int i=tid*4;i<q0+QB;i+=NW*64*4) *(__attribute__((address_space(3))) f32x4a*)(gw+i)=*(const f32x4a*)(Gbh+i);
  const float gq=Gbh[q0+wid*QBLK+r32];
  bf16x8 qr[4];
  #pragma unroll
  for(int d0=0;d0<4;++d0)qr[d0]=*reinterpret_cast<const bf16x8*>(&Qw[(long)r32*DM+d0*16+hi*8]);
  float mhat=0.f,l_reg=0.f;f32x16 o[2];o[0]=f32x16{};o[1]=f32x16{};
  const int qrel=wid*QBLK+r32;
  #define CMASK(P0,P1,t) do{int jb_=(t)-(NT-4); if(jb_>=0&&wid<2*jb_+2)cmask(P0,P1,jb_,qrel,hi);}while(0)
  bool resc=false;
  #define START(P0,P1) do{ const float rm=rowmax(P0,P1); resc=false; \
    { const float dl=rm; mhat=fadd_s(mhat,dl); \
      _Pragma("unroll") for(int r=0;r<16;++r){P0[r]=fsub_s(P0[r],dl);P1[r]=fsub_s(P1[r],dl);} } \
    _Pragma("unroll") for(int r=0;r<16;++r)P0[r]=__builtin_amdgcn_exp2f(P0[r]); }while(0)
  #define RESC() do{ if(resc){ asm volatile("s_waitcnt lgkmcnt(0)":::"memory"); \
      _Pragma("unroll") for(int d_=0;d_<2;++d_) _Pragma("unroll") for(int r=0;r<16;++r)o[d_][r]*=wsf[crow(r,hi)]; } }while(0)
  f32x16 pA0,pA1,pB0,pB1;
  int sl_prev=0,sl_cur=0,sl_next=SLOTB;
  #define ROT() do{sl_prev=sl_cur;sl_cur=sl_next;sl_next=(sl_next==(NSLOT-1)*SLOTB)?0:sl_next+SLOTB;}while(0)
  asm volatile("s_waitcnt vmcnt(0) lgkmcnt(0)":::"memory");
  if(qctr&&tid==0)tknext[0]=nxt_;
  asm volatile("s_waitcnt lgkmcnt(0)\n\ts_barrier":::"memory");
  DMA_K(2,2*SLOTB);
  pre(pA0,pA1,gl,0,hi,gq);
  qkt(pA0,pA1,Kbase,qr,r32,hi);asm volatile("s_nop 15\n\ts_nop 7":"+v"(pA0),"+v"(pA1));
  CMASK(pA0,pA1,0);
  START(pA0,pA1);
  _Pragma("unroll") for(int r=0;r<16;++r)pA1[r]=__builtin_amdgcn_exp2f(pA1[r]);
  WAIT_BAR(0);
  DMA_K(3,0);DMA_V(1,SLOTB);
  ROT();
  kload8(kf,kp0+sl_cur);
  WAIT_BAR(2);
  s16x4 vlo[8],vhi[8]; u32x4 pw0,pw1,pw2,pw3;
  #define PKW(P,B) cvtpk_s(P[B],P[B+1])
  #define PAF(k) __builtin_bit_cast(bf16x8,pw##k)
  #define VFR(i) (bf16x8){vlo[i][0],vlo[i][1],vlo[i][2],vlo[i][3],vhi[i][0],vhi[i][1],vhi[i][2],vhi[i][3]}
  #define PIN(x) asm volatile("":"+v"(x))
  #define MX3(a,b,c) __builtin_fmaxf(__builtin_fmaxf((a),(b)),(c))
  #define GAPA(MF,A0,A1,A2,A3,W0,W1,PW) do{ MF; sacc+=A0; sacc+=A1; sacc+=A2; sacc+=A3; PIN(sacc); W0; W1; PIN(PW); SBAR(); }while(0)
  #define EX(v) __builtin_amdgcn_exp2f(v)
  #define GAPB(MF,X,B) do{ MF; X[B]=EX(X[B]); X[B+1]=EX(X[B+1]); X[B+2]=EX(X[B+2]); X[B+3]=EX(X[B+3]); PIN(X); SBAR(); }while(0)
  #define VRD(i) do{ vlo[i]=vtr(vp_+(((i)>>2)*4096+((i)&3)*1024)); vhi[i]=vtr(vp_+(((i)>>2)*4096+((i)&3)*1024+512)); }while(0)
  #define KRD(G,j) do{ if(G){ kload2(kf,kp0+sl_next,j); SBAR(); } }while(0)
  #define STEP(C0,C1,P0,P1,t,GK,GV,GL) do{ SBAR(); \
    pre(C0,C1,gl,(t),hi,gq-mhat); SBAR(); \
    const lds_cptr vp_=vp0+sl_prev; \
    VRD(0); SBAR(); float sacc=(P0[0]+P0[1]); \
    GAPA(C0=__builtin_amdgcn_mfma_f32_32x32x16_bf16(kf[0],qr[0],C0,0,0,0), P0[2],P0[3],P0[4],P0[5],     pw0[0]=PKW(P0,0), pw0[1]=PKW(P0,2), pw0); \
    VRD(4); SBAR(); GAPA(C1=__builtin_amdgcn_mfma_f32_32x32x16_bf16(kf[1],qr[0],C1,0,0,0), P0[6],P0[7],P0[8],P0[9],     pw0[2]=PKW(P0,4), pw0[3]=PKW(P0,6), pw0); \
    VRD(1); SBAR(); GAPA(C0=__builtin_amdgcn_mfma_f32_32x32x16_bf16(kf[2],qr[1],C0,0,0,0),   P0[10],P0[11],P0[12],P0[13], pw1[0]=PKW(P0,8), pw1[1]=PKW(P0,10), pw1); \
    VRD(5); SBAR(); GAPA(C1=__builtin_amdgcn_mfma_f32_32x32x16_bf16(kf[3],qr[1],C1,0,0,0),   P0[14],P0[15],P1[0],P1[1],   pw1[2]=PKW(P0,12),pw1[3]=PKW(P0,14), pw1); \
    VRD(2); SBAR(); GAPA(C0=__builtin_amdgcn_mfma_f32_32x32x16_bf16(kf[4],qr[2],C0,0,0,0),   P1[2],P1[3],P1[4],P1[5],     pw2[0]=PKW(P1,0), pw2[1]=PKW(P1,2), pw2); \
    VRD(6); SBAR(); GAPA(C1=__builtin_amdgcn_mfma_f32_32x32x16_bf16(kf[5],qr[2],C1,0,0,0),   P1[6],P1[7],P1[8],P1[9],     pw2[2]=PKW(P1,4), pw2[3]=PKW(P1,6), pw2); \
    VRD(3); SBAR(); GAPA(C0=__builtin_amdgcn_mfma_f32_32x32x16_bf16(kf[6],qr[3],C0,0,0,0),   P1[10],P1[11],P1[12],P1[13], pw3[0]=PKW(P1,8), pw3[1]=PKW(P1,10), pw3); \
    VRD(7); SBAR(); GAPA(C1=__builtin_amdgcn_mfma_f32_32x32x16_bf16(kf[7],qr[3],C1,0,0,0),   P1[14],P1[15],0.f,0.f,       pw3[2]=PKW(P1,12),pw3[3]=PKW(P1,14), pw3); \
    l_reg+=sacc; \
    if(GK){DMA_K((t)+3,sl_cur);} if(GV){DMA_V((t)+1,sl_next);} \
    CMASK(C0,C1,t); \
    { float a=MX3(C0[0],C0[1],C1[0]),b=MX3(C0[2],C0[3],C1[1]); a=MX3(a,C1[2],C1[3]); \
      _Pragma("unroll") for(int r=4;r<16;r+=4){a=MX3(a,C0[r],C0[r+1]);b=MX3(b,C0[r+2],C0[r+3]);a=MX3(a,C1[r],C1[r+1]);b=MX3(b,C1[r+2],C1[r+3]);} \
      float rm=__builtin_fmaxf(a,b); { auto rr=__builtin_amdgcn_permlane32_swap(__float_as_uint(rm),__float_as_uint(rm),false,false); rm=__builtin_fmaxf(__uint_as_float(rr[0]),__uint_as_float(rr[1])); } \
      resc=false; \
      if(__builtin_expect(__any(rm>(float)THRL),0)){ const float dl=__builtin_fmaxf(rm,0.f); mhat+=dl; \
        _Pragma("unroll") for(int r=0;r<16;++r){C0[r]-=dl;C1[r]-=dl;} \
        const float f=__builtin_amdgcn_exp2f(-dl); l_reg*=f; if(hi==0)wsf[r32]=f; resc=true; } } \
    SBAR(); \
    GAPB(o[0]=__builtin_amdgcn_mfma_f32_32x32x16_bf16(PAF(0),VFR(0),o[0],0,0,0), C0,0); \
    GAPB(o[1]=__builtin_amdgcn_mfma_f32_32x32x16_bf16(PAF(0),VFR(4),o[1],0,0,0), C0,4); \
    KRD(GL,0); GAPB(o[0]=__builtin_amdgcn_mfma_f32_32x32x16_bf16(PAF(1),VFR(1),o[0],0,0,0), C0,8); \
    KRD(GL,1); GAPB(o[1]=__builtin_amdgcn_mfma_f32_32x32x16_bf16(PAF(1),VFR(5),o[1],0,0,0), C0,12); \
    KRD(GL,2); GAPB(o[0]=__builtin_amdgcn_mfma_f32_32x32x16_bf16(PAF(2),VFR(2),o[0],0,0,0), C1,0); \
    KRD(GL,3); GAPB(o[1]=__builtin_amdgcn_mfma_f32_32x32x16_bf16(PAF(2),VFR(6),o[1],0,0,0), C1,4); \
    GAPB(o[0]=__builtin_amdgcn_mfma_f32_32x32x16_bf16(PAF(3),VFR(3),o[0],0,0,0), C1,8); \
    GAPB(o[1]=__builtin_amdgcn_mfma_f32_32x32x16_bf16(PAF(3),VFR(7),o[1],0,0,0), C1,12); \
    }while(0)
  int t=1;
  #undef CMASK
  #define CMASK(P0,P1,t) do{}while(0)
  for(;t+5<NT;t+=2){
    STEP(pB0,pB1,pA0,pA1,t,true,true,true);     WAIT_BAR(2); RESC(); ROT();
    STEP(pA0,pA1,pB0,pB1,t+1,true,true,true);   WAIT_BAR(2); RESC(); ROT();
  }
  #undef CMASK
  #define CMASK(P0,P1,t) do{int jb_=(t)-(NT-4); if(jb_>=0&&wid<2*jb_+2)cmask(P0,P1,jb_,qrel,hi);}while(0)
  #define ENDW(tt) do{ if((tt)+3<NT){WAIT_BAR(2);} else if((tt)+2<NT){WAIT_BAR(1);} else {WAIT_BAR(0);} }while(0)
  for(;t+1<NT;t+=2){
    STEP(pB0,pB1,pA0,pA1,t,(t+3<NT),(t+1<NT),(t+1<NT));       ENDW(t);   RESC(); ROT();
    STEP(pA0,pA1,pB0,pB1,t+1,(t+4<NT),(t+2<NT),(t+2<NT));     ENDW(t+1); RESC(); ROT();
  }
  STEP(pB0,pB1,pA0,pA1,NT-1,false,false,false); RESC();
  { float sacc=pB0[0]+pB0[1]; _Pragma("unroll") for(int r=2;r<16;++r)sacc+=pB0[r]; _Pragma("unroll") for(int r=0;r<16;++r)sacc+=pB1[r]; l_reg+=sacc;
    pw0=(u32x4){PKW(pB0,0),PKW(pB0,2),PKW(pB0,4),PKW(pB0,6)};pw1=(u32x4){PKW(pB0,8),PKW(pB0,10),PKW(pB0,12),PKW(pB0,14)};pw2=(u32x4){PKW(pB1,0),PKW(pB1,2),PKW(pB1,4),PKW(pB1,6)};pw3=(u32x4){PKW(pB1,8),PKW(pB1,10),PKW(pB1,12),PKW(pB1,14)};
    SBAR(); pv(o,vb0+sl_cur,PAF(0),PAF(1),PAF(2),PAF(3)); }
  #undef PKW
  #undef PAF
  #undef VFR
  #undef PIN
  #undef MX3
  #undef GAPA
  #undef GAPB
  #undef EX
  #undef VRD
  #undef KRD
  #undef STEP
  #undef ENDW
  {auto rr=__builtin_amdgcn_permlane32_swap(__float_as_uint(l_reg),__float_as_uint(l_reg),false,false);l_reg=__uint_as_float(rr[0])+__uint_as_float(rr[1]);}
  if(hi==0)wsf[32+r32]=l_reg;asm volatile("s_waitcnt lgkmcnt(0)":::"memory");
  float rli[16];
  #pragma unroll
  for(int r=0;r<16;++r)rli[r]=__builtin_amdgcn_rcpf(wsf[32+crow(r,hi)]);
  bf16*Ow=O+(rowbase+q0+wid*QBLK)*DM+h*D;
  { bf16*stg=(bf16*)(shm+LDS_OST)+wid*2048;
    #pragma unroll
    for(int r=0;r<16;++r){const int orow=crow(r,hi);
      #pragma unroll
      for(int d0=0;d0<2;++d0)stg[orow*64+d0*32+r32]=__float2bfloat16(o[d0][r]*rli[r]);}
    asm volatile("s_waitcnt lgkmcnt(0)":::"memory");
    #pragma unroll
    for(int i=0;i<4;++i){const int row=i*8+(lane>>3),ch=lane&7; const u32x4 v=*(const u32x4*)(stg+row*64+ch*8); ATTN_STORE16(Ow+(long)row*DM+ch*8,v);} }
  asm volatile("s_waitcnt lgkmcnt(0)\n\ts_barrier":::"memory");
  #undef DMA_K
  #undef DMA_V
  #undef CMASK
  #undef START
  #undef RESC
  #undef ROT
}
constexpr int ATTN_LDS_BYTES=LDS_BYTES;
struct AttnUnit { int bh; int qb; };
struct StaticOrder {
  int vcu;
  __device__ __forceinline__ explicit StaticOrder(int grid,int block):vcu((block%8)*(grid/8)+block/8){}
  __device__ __forceinline__ bool next(int i,AttnUnit&u)const{ if(i>=8)return false; const int s=vcu&7,k=i&3; u.bh=(vcu>>3)+32*(i>>2); u.qb=(k==0)?s:(k==1)?15-s:(k==2)?16+s:31-s; return true; }
};
#undef SBAR
#undef WAIT_BAR
}

constexpr int NWAVES = 8;
#ifndef MK_PER_PHASE
#define MK_PER_PHASE 0
#endif
constexpr size_t MiB = 1u << 20;
constexpr size_t WS_CTL = 0, CTL_ZERO_BYTES = 64 * 1024;
constexpr size_t WS_T0 = 256 * 1024;
constexpr size_t WS_VEC = 1 * MiB;
constexpr size_t WS_WFIN = 2 * MiB;
constexpr size_t WS_WFOUT = WS_WFIN + 88 * MiB;
constexpr size_t WS_WQKV = WS_WFOUT + 44 * MiB;
constexpr size_t WS_WGATE = WS_WQKV + 12 * MiB;
constexpr size_t WS_WWO = WS_WGATE + 1 * MiB;
constexpr size_t WS_WPOOL = WS_WWO + 4 * MiB;
constexpr size_t WS_WPROJ = WS_WPOOL + 1 * MiB;
constexpr size_t WS_WGW = WS_WPROJ + 2 * MiB;
constexpr size_t WS_Z = WS_WGW + 8 * MiB;
constexpr size_t WS_ZB0 = WS_Z + 130 * MiB, WS_ZB1 = WS_ZB0 + 65 * MiB;
constexpr size_t WS_ST0 = WS_ZB1 + 65 * MiB, WS_ST1 = WS_ST0 + 9 * MiB;
constexpr size_t WS_R = WS_ST1 + 9 * MiB;
constexpr size_t WS_PB = WS_R + 195 * MiB;
constexpr size_t WS_G = WS_PB + 65 * MiB;
constexpr size_t WS_END = WS_G + 2 * MiB;
static_assert(WS_Z == 162 * MiB && WS_END == 702 * MiB, "d_ws map");
static_assert((size_t)M * D * 4 <= 130 * MiB && (size_t)M * D * 2 <= 65 * MiB && (size_t)M * 64 * 4 <= 9 * MiB && (size_t)M * DFF * 2 <= 195 * MiB && (size_t)4 * M * PLE * 2 <= 65 * MiB, "d_ws sizes");
constexpr int V_ONES = 0, V_ZEROS = 1024, V_FIN = 2048, V_QKV = V_FIN + 8 * 11264, V_GATE = V_QKV + 2 * 6144, V_GW = V_GATE + 64, V_END = V_GW + 4 * 2048;
static_assert(V_END * 4 <= (int)MiB, "vector region");
constexpr size_t O_YP = 0, O_YS = (size_t)MP * D, O_KP = O_YS + (size_t)MS * D, O_VP = O_KP + 2ull * MP * D, O_FP = O_VP + 2ull * MP * D, O_PP = O_FP + 2ull * MP * NH,
                 O_KS = O_PP + 2ull * NB * 15 * D, O_VS = O_KS + 2ull * MS * D, O_FS = O_VS + 2ull * MS * D, O_PS = O_FS + 2ull * MS * NH, O_END = O_PS + 2ull * DECB * 15 * D;
static_assert(O_END == 172564480ull, "output size");
constexpr int CW_BAR = 4096, CW_QUEUE = 8192;
constexpr float FOX_SKIP = 64.0f;
constexpr int RING_OFF = 0, RING_BYTES = 131072, LDSCTL_OFF = RING_BYTES, MISC_OFF = LDSCTL_OFF + 320, STAT_OFF = RING_BYTES + 512, STAT_UNITS = 11, LDS_BYTES = 163840;
constexpr int EVEC_OFF = STAT_OFF + STAT_UNITS * 256 * 8;
static_assert(EVEC_OFF + 2 * 512 * 4 <= LDS_BYTES, "LDS map");

#define GAS __attribute__((address_space(1)))
#define LAS __attribute__((address_space(3)))
typedef unsigned short bf16;
typedef unsigned v4u __attribute__((ext_vector_type(4)));
typedef unsigned v2u __attribute__((ext_vector_type(2)));
typedef float f32x4 __attribute__((ext_vector_type(4)));
typedef float f32x2 __attribute__((ext_vector_type(2)));
typedef short bf16x8 __attribute__((ext_vector_type(8)));
typedef short bf16x4 __attribute__((ext_vector_type(4)));
typedef GAS unsigned gu32;
#define RLX_AGENT __ATOMIC_RELAXED, __HIP_MEMORY_SCOPE_AGENT
#define LDS_WAIT() asm volatile("s_waitcnt lgkmcnt(0)" ::: "memory")
__device__ __forceinline__ unsigned f2bf(float f) { unsigned u = __builtin_bit_cast(unsigned, f); return (u + 0x7fffu + ((u >> 16) & 1u)) >> 16; }
__device__ __forceinline__ unsigned pk2(float lo, float hi) { return f2bf(lo) | (f2bf(hi) << 16); }
__device__ __forceinline__ float bf2f(unsigned b) { return __uint_as_float(b << 16); }

#define XB_TMO      128
#define XB_XCNT(j)  (256  + 64 * (j))
#define XB_XSUB(j)  (1280 + 64 * (j))
#define XB_XGEN(j)  (2304 + 64 * (j))
#define XB_TOP      3328
#define XB_TOPGEN   3392
#define XCD_BAR_WORDS 3456
#define XB_SPIN_CAP (1u << 18)
__device__ __forceinline__ unsigned xb_ld(unsigned* p)              { return __hip_atomic_load(p, __ATOMIC_RELAXED, __HIP_MEMORY_SCOPE_AGENT); }
__device__ __forceinline__ unsigned xb_add(unsigned* p, unsigned v) { return __hip_atomic_fetch_add(p, v, __ATOMIC_RELAXED, __HIP_MEMORY_SCOPE_AGENT); }
__device__ __forceinline__ unsigned xb_xcc_id() { return (unsigned)__builtin_amdgcn_s_getreg((3 << 11) | 20) & 0xFu; }
#define XB_SPIN(cond, bar) do { unsigned _sp = 0; while (cond) { __builtin_amdgcn_s_sleep(1); \
    if ((++_sp & 255u) == 0u) { if (xb_ld(&(bar)[XB_TMO])) break; if (_sp > XB_SPIN_CAP) { atomicAdd(&(bar)[XB_TMO], 1u); break; } } } } while (0)
struct XcdBarrier { unsigned* bar; unsigned x; volatile LAS unsigned* st; };
__device__ __forceinline__ XcdBarrier xcd_barrier_post(unsigned* bar, volatile LAS unsigned* st) {
    XcdBarrier b; b.bar = bar; b.x = xb_xcc_id(); b.st = st;
    if (threadIdx.x == 0) (void)xb_add(&bar[XB_XCNT(b.x)], 1u);
    return b;
}
__device__ __forceinline__ void xcd_barrier_complete(unsigned* bar, unsigned x, unsigned& nloc, unsigned& nx) {
    const unsigned G = gridDim.x * gridDim.y * gridDim.z;
    unsigned sum, cnt, mine, sp = 0u;
    for (;;) {
        sum = 0u; cnt = 0u; mine = 0u;
#pragma unroll
        for (unsigned j = 0; j < 16; ++j) { const unsigned c = xb_ld(&bar[XB_XCNT(j)]); sum += c; cnt += (c > 0u) ? 1u : 0u; mine = (j == x) ? c : mine; }
        if (sum == G) break;
        __builtin_amdgcn_s_sleep(1);
        if ((++sp & 255u) == 0u) { if (xb_ld(&bar[XB_TMO])) break; if (sp > XB_SPIN_CAP) { atomicAdd(&bar[XB_TMO], 1u); break; } }
    }
    nloc = mine > 0u ? mine : 1u; nx = cnt > 0u ? cnt : 1u;
}
__device__ __forceinline__ void xcd_barrier(const XcdBarrier& b) {
    asm volatile("s_waitcnt vmcnt(0)" ::: "memory");
    __syncthreads();
    if (threadIdx.x == 0) {
        unsigned* bar = b.bar; asm volatile("" : "+s"(bar));
        __builtin_amdgcn_s_waitcnt(0);
        unsigned nloc = b.st[0], nx = b.st[1];
        if (nloc == 0u) { xcd_barrier_complete(bar, b.x, nloc, nx); b.st[0] = nloc; b.st[1] = nx; }
        const unsigned old = xb_add(&bar[XB_XSUB(b.x)], 1u);
        const unsigned gen = old / nloc;
        if (old + 1u == (gen + 1u) * nloc) {
            __builtin_amdgcn_fence(__ATOMIC_RELEASE, "agent");
            asm volatile("s_waitcnt vmcnt(0)" ::: "memory");
            const unsigned og = xb_add(&bar[XB_TOP], 1u);
            const unsigned tg = og / nx;
            if (og + 1u == (tg + 1u) * nx) xb_add(&bar[XB_TOPGEN], 1u);
            else XB_SPIN(xb_ld(&bar[XB_TOPGEN]) == tg, bar);
            __builtin_amdgcn_fence(__ATOMIC_ACQUIRE, "agent");
            xb_add(&bar[XB_XGEN(b.x)], 1u);
            asm volatile("s_waitcnt vmcnt(0)" ::: "memory");
        } else {
            XB_SPIN(xb_ld(&bar[XB_XGEN(b.x)]) == gen, bar);
            __builtin_amdgcn_fence(__ATOMIC_ACQUIRE, "agent");
            asm volatile("s_waitcnt vmcnt(0)" ::: "memory");
        }
    }
    __syncthreads();
}

struct Args { const float* in[20]; float* out; unsigned char* ws; int ph_lo, ph_hi; };
struct Base { LAS unsigned char* lds; int wave, G; };
struct Frame {
    LAS unsigned char* lds;
    int tid, lane, wave, vcu, G, bx;
    const float *x_p, *x_s, *ck, *cv, *clf, *spool, *p_p, *p_s, *ln_g, *ln_b, *w_fin, *w_fout, *w_fox, *b_f, *w_o, *w_pool, *pool_scale, *w_proj, *w_gate, *b_gate;
    float* out; unsigned char* ws;
    float* vec;
    float* Z; bf16* R; bf16* PB; float* GT;
};
typedef const Args __attribute__((address_space(4)))* KArgs;
__device__ __forceinline__ Frame mkframe(const Base& B) {
    KArgs ka = (KArgs)__builtin_amdgcn_kernarg_segment_ptr(); asm volatile("" : "+s"(ka));
    int tid; asm volatile("v_mbcnt_lo_u32_b32 %0, -1, 0\n\tv_mbcnt_hi_u32_b32 %0, -1, %0" : "=v"(tid)); tid += B.wave * 64;
    Frame F; F.lds = B.lds; F.tid = tid; F.lane = tid & 63; F.wave = __builtin_amdgcn_readfirstlane(tid >> 6);
    { int g_ = B.G, b_ = blockIdx.x; asm volatile("" : "+s"(g_), "+s"(b_)); F.G = g_; F.bx = b_; F.vcu = (g_ % 8 == 0) ? (b_ % 8) * (g_ / 8) + b_ / 8 : b_; }
#define GP(k) ((const float*)(const GAS float*)ka->in[k])
    F.x_p = GP(0); F.x_s = GP(1); F.ck = GP(2); F.cv = GP(3); F.clf = GP(4); F.spool = GP(5); F.p_p = GP(6); F.p_s = GP(7);
    F.ln_g = GP(8); F.ln_b = GP(9); F.w_fin = GP(10); F.w_fout = GP(11); F.w_fox = GP(12); F.b_f = GP(13); F.w_o = GP(14);
    F.w_pool = GP(15); F.pool_scale = GP(16); F.w_proj = GP(17); F.w_gate = GP(18); F.b_gate = GP(19);
#undef GP
    F.out = (float*)(GAS float*)ka->out; unsigned char* ws = (unsigned char*)(GAS unsigned char*)ka->ws; F.ws = ws;
    F.vec = (float*)(ws + WS_VEC); F.Z = (float*)(ws + WS_Z); F.R = (bf16*)(ws + WS_R); F.PB = (bf16*)(ws + WS_PB); F.GT = (float*)(ws + WS_G);
    return F;
}
__device__ __forceinline__ bf16* zbk(const Frame& F, int k) { return (bf16*)(F.ws + WS_ZB0 + (size_t)(k & 1) * (WS_ZB1 - WS_ZB0)); }
__device__ __forceinline__ float* stk(const Frame& F, int k) { return (float*)(F.ws + WS_ST0 + (size_t)(k & 1) * (WS_ST1 - WS_ST0)); }
__device__ __forceinline__ const float* ln_gk(const Frame& F, int k) { return k == 0 ? F.vec + V_ONES : F.ln_g + (size_t)(k - 1) * D; }
__device__ __forceinline__ const float* ln_bk(const Frame& F, int k) { return k == 0 ? F.vec + V_ZEROS : F.ln_b + (size_t)(k - 1) * D; }
__device__ __forceinline__ float wave_incl_scan(float v, int lane) {
#pragma unroll
    for (int o = 1; o < 64; o <<= 1) { const float t = bperm(v, lane - o); if (lane >= o) v += t; }
    return v;
}
__device__ __forceinline__ void row_stats_full(const float* st, int row, float& mu, float& rs) {
    const f32x4* p = (const f32x4*)(st + (size_t)row * 64);
    float s = 0.f, q = 0.f;
#pragma unroll
    for (int i = 0; i < 16; ++i) { const f32x4 a = p[i]; s += a[0] + a[2]; q += a[1] + a[3]; }
    mu = s * (1.0f / 1024.0f);
    const float var = fmaxf(q * (1.0f / 1024.0f) - mu * mu, 0.f);
    rs = 1.0f / sqrtf(var + LN_EPS);
}

template <class Sched> __device__ __forceinline__ void stats_to_lds(const Frame& F, const Sched& S, const float* st) {
    LAS f32x2* T = (LAS f32x2*)(F.lds + STAT_OFF);
    pg8::Unit u;
    int ppm = -1;
    for (int i = 0; i < STAT_UNITS && S.next(i, u); ++i) {
        if (u.pm == ppm) continue;
        ppm = u.pm;
        if (S.first_same_pm(i, u.pm) != i) continue;
        const int r = F.tid >> 1, h = F.tid & 1;
        const f32x4* p = (const f32x4*)(st + ((size_t)(u.pm * 256 + r) * 64 + h * 32));
        float s = 0.f, q = 0.f;
#pragma unroll
        for (int k = 0; k < 8; ++k) { const f32x4 a = p[k]; s += a[0] + a[2]; q += a[1] + a[3]; }
        const float s2 = bperm(s, F.lane ^ 1), q2 = bperm(q, F.lane ^ 1);
        const float st_ = h ? s2 + s : s + s2, qt_ = h ? q2 + q : q + q2;
        const float mu = st_ * (1.0f / 1024.0f), var = fmaxf(qt_ * (1.0f / 1024.0f) - mu * mu, 0.f);
        if (h == 0) T[i * 256 + r] = (f32x2){mu, 1.0f / sqrtf(var + LN_EPS)};
    }
    __syncthreads();
}

template <class Sched> struct StatsHook { static constexpr bool REAL = true; const Frame& F; const Sched& S; const float* st; __device__ __forceinline__ void operator()() const { stats_to_lds(F, S, st); } };

__device__ __forceinline__ void tr_item(const float* src, int ldsrc, int c0, int K, bf16* dst, const float* g, const float* b, float* gWo, float* bWo, const float* extra, int nvalid, LAS float* scr, int lane, bool f16 = false, int kb = 0, int ke = -1) {
    if (ke < 0) ke = K;
    float gs[4] = {0.f, 0.f, 0.f, 0.f}, bs[4] = {0.f, 0.f, 0.f, 0.f};
    const int c = lane & 7, nb = lane >> 3, nn = lane & 31;
    const float* sp = src + (size_t)(kb + (lane >> 5)) * ldsrc + c0 + nn;
    float cur[32];
#pragma unroll
    for (int i = 0; i < 32; ++i) cur[i] = (nn < nvalid) ? __builtin_nontemporal_load(sp + (size_t)(2 * i) * ldsrc) : 0.f;
    for (int k0 = kb; k0 < ke; k0 += 64) {
#pragma unroll
        for (int i = 0; i < 32; ++i) scr[(2 * i + (lane >> 5)) * 33 + nn] = cur[i];
        if (k0 + 64 < ke) {
            const float* spn = sp + (size_t)(k0 + 64 - kb) * ldsrc;
#pragma unroll
            for (int i = 0; i < 32; ++i) cur[i] = (nn < nvalid) ? __builtin_nontemporal_load(spn + (size_t)(2 * i) * ldsrc) : 0.f;
        }
        float gk[8], bk[8];
#pragma unroll
        for (int e = 0; e < 8; ++e) { gk[e] = g ? g[k0 + 8 * c + e] : 1.0f; bk[e] = b ? b[k0 + 8 * c + e] : 0.f; }
        LDS_WAIT(); asm volatile("" ::: "memory");
#pragma unroll
        for (int j = 0; j < 4; ++j) { const int n = nb + 8 * j; const LAS float* s = scr + (8 * c) * 33 + n;
            unsigned r[8];
#pragma unroll
            for (int e = 0; e < 8; ++e) { const float w = s[e * 33]; if (f16) { const _Float16 h = (_Float16)(w * gk[e]); r[e] = __builtin_bit_cast(unsigned short, h); gs[j] += (float)h; } else { r[e] = f2bf(w * gk[e]); gs[j] += bf2f(r[e]); } bs[j] += bk[e] * w; }
            v4u o; o.x = r[0] | (r[1] << 16); o.y = r[2] | (r[3] << 16); o.z = r[4] | (r[5] << 16); o.w = r[6] | (r[7] << 16);
            if (n < nvalid) *(GAS v4u*)(dst + (size_t)n * K + k0 + 8 * c) = o; }
        LDS_WAIT(); asm volatile("" ::: "memory");
    }
    if (gWo) {
#pragma unroll
        for (int j = 0; j < 4; ++j) { float a = gs[j], bb = bs[j];
            a += bperm(a, lane ^ 1); a += bperm(a, lane ^ 2); a += bperm(a, lane ^ 4); bb += bperm(bb, lane ^ 1); bb += bperm(bb, lane ^ 2); bb += bperm(bb, lane ^ 4);
            const int n = nb + 8 * j; if (c == 0 && n < nvalid) { gWo[n] = a; bWo[n] = bb + (extra ? extra[n] : 0.f); } }
    }
}
__device__ __forceinline__ void p0_prologue(Frame& F) {
    LAS float* scr = (LAS float*)(F.lds + RING_OFF + F.wave * 16384);
    const int gw = F.wave * F.G + F.vcu, NGW = F.G * NWAVES;
    constexpr int I_FOUT = 8 * 32 * 4, I_FIN = 8 * 176, I_QKV = 2 * 96, I_WO = 2 * 32, I_GW = 4 * 32, I_PROJ = 4 * 32, I_POOL = 2 * 4 * 8, I_GATE = 2;
    constexpr int NITEMS = I_FOUT + I_FIN + I_QKV + I_WO + I_GW + I_PROJ + I_POOL + I_GATE;
    for (int it = gw; it < NITEMS; it += NGW) {
        int r = it;
        if (r < I_FOUT) { const int f = r / 128, nb = (r % 128) >> 2, kq = r & 3;
            tr_item(F.w_fout + (size_t)f * DFF * D, D, nb * 32, DFF, (bf16*)(F.ws + WS_WFOUT) + (size_t)f * D * DFF + (size_t)nb * 32 * DFF, nullptr, nullptr, nullptr, nullptr, nullptr, 32, scr, F.lane, false, kq * 704, kq * 704 + 704); continue; } r -= I_FOUT;
        if (r < I_FIN) { const int f = r / 176, nb = r % 176, n0 = nb * 32, i = f >> 1, s = f & 1, kin = 4 * i + 2 * s;
            const int pn = n0 >> 8, w = n0 & 255, c0 = (w < 128 ? 0 : DFF) + pn * 128 + (w & 127);
            tr_item(F.w_fin + (size_t)f * D * 2 * DFF, 2 * DFF, c0, D, (bf16*)(F.ws + WS_WFIN) + (size_t)f * 2 * DFF * D + (size_t)n0 * D, kin == 0 ? nullptr : ln_gk(F, kin), kin == 0 ? nullptr : ln_bk(F, kin),
                    F.vec + V_FIN + f * 11264 + n0, F.vec + V_FIN + f * 11264 + 5632 + n0, nullptr, 32, scr, F.lane, !ZBF_E); continue; } r -= I_FIN;
        if (r < I_QKV) { const int j = r / 96, nb = r % 96, n0 = nb * 32, kin = 8 * j + 1;
            tr_item(F.w_fox + (size_t)j * D * 3088, 3088, n0, D, (bf16*)(F.ws + WS_WQKV) + (size_t)j * 3072 * D + (size_t)n0 * D, ln_gk(F, kin), ln_bk(F, kin),
                    F.vec + V_QKV + j * 6144 + n0, F.vec + V_QKV + j * 6144 + 3072 + n0, nullptr, 32, scr, F.lane, !ZBF_O); continue; } r -= I_QKV;
        if (r < I_WO) { const int j = r / 32, nb = r % 32;
            tr_item(F.w_o + (size_t)j * D * D, D, nb * 32, D, (bf16*)(F.ws + WS_WWO) + (size_t)j * D * D + (size_t)nb * 32 * D, nullptr, nullptr, nullptr, nullptr, nullptr, 32, scr, F.lane); continue; } r -= I_WO;
        if (r < I_GW) { const int i = r / 32, nb = r % 32, n0 = nb * 32, kin = 4 * i + 3;
            tr_item(F.w_gate + (size_t)i * D * D, D, n0, D, (bf16*)(F.ws + WS_WGW) + (size_t)i * D * D + (size_t)n0 * D, ln_gk(F, kin), ln_bk(F, kin),
                    F.vec + V_GW + i * 2048 + n0, F.vec + V_GW + i * 2048 + 1024 + n0, F.b_gate + (size_t)i * D + n0, 32, scr, F.lane, !ZBF_O); continue; } r -= I_GW;
        if (r < I_PROJ) { const int i = r / 32, nb = r % 32;
            tr_item(F.w_proj + (size_t)i * PLE * D, D, nb * 32, PLE, (bf16*)(F.ws + WS_WPROJ) + (size_t)i * D * PLE + (size_t)nb * 32 * PLE, nullptr, nullptr, nullptr, nullptr, nullptr, 32, scr, F.lane); continue; } r -= I_PROJ;
        if (r < I_POOL) { const int jg = r / 8, nb = r % 8;
            tr_item(F.w_pool + (size_t)jg * 256 * 256, 256, nb * 32, 256, (bf16*)(F.ws + WS_WPOOL) + (size_t)jg * 256 * 256 + (size_t)nb * 32 * 256, nullptr, nullptr, nullptr, nullptr, nullptr, 32, scr, F.lane); continue; } r -= I_POOL;
        { const int j = r, kin = 8 * j + 1;
            tr_item(F.w_fox + (size_t)j * D * 3088, 3088, 3072, D, (bf16*)(F.ws + WS_WGATE) + (size_t)j * 16 * D, ln_gk(F, kin), ln_bk(F, kin),
                    F.vec + V_GATE + j * 32, F.vec + V_GATE + j * 32 + 16, F.b_f + j * 16, 16, scr, F.lane, !ZBF_O); }
    }
    const size_t gt = (size_t)gw * 64 + F.lane, GT_ = (size_t)NGW * 64;
#define CVT_STREAM(src, dst, n, PK) do { const float* s_ = (src); bf16* d_ = (dst); const size_t n_ = (n); \
        for (size_t e0 = gt * 8; e0 < n_; e0 += GT_ * 32) { f32x4 a_[4], b_[4]; \
            _Pragma("unroll") for (int u_ = 0; u_ < 4; ++u_) { const size_t e = e0 + (size_t)u_ * GT_ * 8; if (e < n_) { a_[u_] = __builtin_nontemporal_load((const f32x4*)(s_ + e)); b_[u_] = __builtin_nontemporal_load((const f32x4*)(s_ + e + 4)); } } \
            _Pragma("unroll") for (int u_ = 0; u_ < 4; ++u_) { const size_t e = e0 + (size_t)u_ * GT_ * 8; if (e < n_) { v4u w; w.x = PK(a_[u_][0], a_[u_][1]); w.y = PK(a_[u_][2], a_[u_][3]); w.z = PK(b_[u_][0], b_[u_][1]); w.w = PK(b_[u_][2], b_[u_][3]); *(GAS v4u*)(d_ + e) = w; } } } } while (0)
    CVT_STREAM(F.x_p, zbk(F, 0), (size_t)MP * D, pkz<ZBF_E>);
    CVT_STREAM(F.x_s, zbk(F, 0) + (size_t)MP * D, (size_t)MS * D, pkz<ZBF_E>);
#pragma unroll 1
    for (int i = 0; i < DEPTH; ++i) {
        CVT_STREAM(F.p_p + (size_t)i * MP * PLE, F.PB + (size_t)i * M * PLE, (size_t)MP * PLE, pk2);
        CVT_STREAM(F.p_s + (size_t)i * MS * PLE, F.PB + ((size_t)i * M + MP) * PLE, (size_t)MS * PLE, pk2);
    }
#undef CVT_STREAM
    { const f32x4 idv = {0.f, 32.0f * (1.0f - LN_EPS), 0.f, 32.0f * (1.0f - LN_EPS)}; float* st0 = stk(F, 0);
      for (size_t e = gt * 4; e < (size_t)M * 64; e += GT_ * 4) *(GAS f32x4*)(st0 + e) = idv; }
    if (gw == 0) { for (int e = F.lane; e < 1024; e += 64) { F.vec[V_ONES + e] = 1.0f; F.vec[V_ZEROS + e] = 0.f; } }
}

__device__ __forceinline__ void ln_row_out(const Frame& F, int k, int m, float* dst) {
    float mu, rs; row_stats_full(stk(F, k), m, mu, rs);
    const GAS v2u* zi = (const GAS v2u*)(zbk(F, k) + (size_t)m * D) + F.lane; const GAS f32x4* gi = (const GAS f32x4*)ln_gk(F, k) + F.lane; const GAS f32x4* bi = (const GAS f32x4*)ln_bk(F, k) + F.lane;
    GAS f32x4* o = (GAS f32x4*)dst + F.lane;
#pragma unroll
    for (int j = 0; j < 4; ++j) { const v2u w = zi[64 * j]; const f32x2g lo_ = upz<ZBF_O>(w.x), hi_ = upz<ZBF_O>(w.y); const f32x4 zv = {lo_.x, lo_.y, hi_.x, hi_.y};
        __builtin_nontemporal_store((zv - mu) * rs * gi[64 * j] + bi[64 * j], (f32x4*)(o + 64 * j)); }
}
__device__ __forceinline__ void gate_proj(const Frame& F, int j, int kin) {
    const int gw = F.vcu * NWAVES + F.wave, NGW = F.G * NWAVES, n16 = F.lane & 15, quad = F.lane >> 4;
    const bf16* A = zbk(F, kin); const bf16* W = (const bf16*)(F.ws + WS_WGATE) + (size_t)j * 16 * D;
    const float gWh = F.vec[V_GATE + j * 32 + n16], bWh = F.vec[V_GATE + j * 32 + 16 + n16];
    for (int it = gw; it < M / 16; it += 2 * NGW) {
        const int it2 = it + NGW; const bool two = it2 < M / 16;
        const int r0 = it * 16, r1 = (two ? it2 : it) * 16;
        float mu0 = 0.f, rs0 = 1.f, mu1 = 0.f, rs1 = 1.f;
        if (F.lane < 16) { row_stats_full(stk(F, kin), r0 + F.lane, mu0, rs0); if (two) row_stats_full(stk(F, kin), r1 + F.lane, mu1, rs1); }
        f32x4 acc0 = {0.f, 0.f, 0.f, 0.f}, acc1 = {0.f, 0.f, 0.f, 0.f};
        const bf16* ap0 = A + (size_t)(r0 + n16) * D + 8 * quad; const bf16* ap1 = A + (size_t)(r1 + n16) * D + 8 * quad; const bf16* wp = W + (size_t)n16 * D + 8 * quad;
#define GP_MMA(a_, b_, c_) (ZBF_O ? __builtin_amdgcn_mfma_f32_16x16x32_bf16(a_, b_, c_, 0, 0, 0) : __builtin_amdgcn_mfma_f32_16x16x32_f16(__builtin_bit_cast(h16x8, a_), __builtin_bit_cast(h16x8, b_), c_, 0, 0, 0))
        if (two) {
#pragma unroll 8
            for (int s = 0; s < 32; ++s) { const bf16x8 a0 = *(const bf16x8*)(ap0 + 32 * s), a1 = *(const bf16x8*)(ap1 + 32 * s), b = *(const bf16x8*)(wp + 32 * s); acc0 = GP_MMA(a0, b, acc0); acc1 = GP_MMA(a1, b, acc1); }
        } else {
#pragma unroll 16
            for (int s = 0; s < 32; ++s) { const bf16x8 a0 = *(const bf16x8*)(ap0 + 32 * s), b = *(const bf16x8*)(wp + 32 * s); acc0 = GP_MMA(a0, b, acc0); }
        }
#undef GP_MMA
        for (int blk = 0; blk < (two ? 2 : 1); ++blk) {
            const f32x4 acc = blk ? acc1 : acc0; const float mu = blk ? mu1 : mu0, rs = blk ? rs1 : rs0; const int rb = blk ? r1 : r0;
#pragma unroll
            for (int e = 0; e < 4; ++e) { const int rr = 4 * quad + e; const float m_ = bperm(mu, rr), r_ = bperm(rs, rr);
                const float zl = r_ * (acc[e] - m_ * gWh) + bWh;
                const float t_ = __builtin_amdgcn_exp2f(-LOG2E * fabsf(zl));
                const float l1p = (t_ < 0.03f) ? t_ * (1.0f - t_ * (0.5f - t_ * (0.33333334f - 0.25f * t_))) : __builtin_amdgcn_logf(1.0f + t_) * 0.6931471805599453f;
                const float lf = fminf(zl, 0.f) - l1p;
                const int row = rb + rr;
                float* o = (row < MP) ? F.out + O_FP + ((size_t)j * MP + row) * NH + n16 : F.out + O_FS + ((size_t)j * MS + (row - MP)) * NH + n16;
                *o = lf; }
        }
    }
}
__device__ __forceinline__ void fox_scan(const Frame& F, int j) {
    if (F.bx >= NB * NH) return;
    const int bh = F.bx, b = bh >> 4, h = bh & 15, t0 = F.tid * 16;
    const float* lf = F.out + O_FP + ((size_t)j * MP + (size_t)b * SEQ + t0) * NH + h;
    LAS float* wt = (LAS float*)(F.lds + RING_OFF);
    float v[16]; float run = 0.f;
#pragma unroll
    for (int i = 0; i < 16; ++i) v[i] = lf[(size_t)i * NH];
#pragma unroll
    for (int i = 0; i < 16; ++i) { run += v[i]; v[i] = run; }
    const float incl = wave_incl_scan(run, F.lane);
    if (F.lane == 63) wt[F.wave] = incl;
    __syncthreads();
    float base = incl - run;
#pragma unroll
    for (int w = 0; w < NWAVES; ++w) if (w < F.wave) base += wt[w];
    float* g = F.GT + (size_t)bh * SEQ + t0;
#pragma unroll
    for (int i = 0; i < 4; ++i) *(GAS f32x4*)(g + 4 * i) = (f32x4){(base + v[4 * i]) * LOG2E, (base + v[4 * i + 1]) * LOG2E, (base + v[4 * i + 2]) * LOG2E, (base + v[4 * i + 3]) * LOG2E};
    LAS float* ge = wt + 64; LAS float* gtp = wt + 192;
    if ((F.tid & 3) == 3) ge[F.tid >> 2] = (base + v[15]) * LOG2E;
    if ((F.tid & 15) == 0) gtp[F.tid >> 4] = (base + v[0]) * LOG2E;
    __syncthreads();
    if (F.tid < 32) { const int qb = F.tid, NT0 = 4 * qb + 4; const float gtop = gtp[qb]; int cnt = 0;
        for (int T = 0; T < NT0; ++T) cnt += (gtop - ge[T] < -FOX_SKIP) ? 1 : 0;
        int t0 = cnt & ~1; if (t0 > NT0 - 4) t0 = NT0 - 4;
        ((GAS int*)(F.ws + WS_T0))[(j * 64 + bh) * 32 + qb] = t0; }
    __syncthreads();
}
__device__ __forceinline__ void sample_attn_item(const Frame& F, int j, int b, int h) {
    const int n16 = F.lane & 15, quad = F.lane >> 4;
    const float* ck = F.ck + ((size_t)(j * DECB + b) * PAST) * D + h * HD; const float* cv = F.cv + ((size_t)(j * DECB + b) * PAST) * D + h * HD;
    const float* clf = F.clf + ((size_t)(j * DECB + b) * PAST) * NH + h;
    const float* kn = F.out + O_KS + ((size_t)j * MS + b * DECS) * D + h * HD; const float* vn = F.out + O_VS + ((size_t)j * MS + b * DECS) * D + h * HD;
    const float* lfn = F.out + O_FS + ((size_t)j * MS + b * DECS) * NH + h;
    bf16* qo = F.R + (size_t)(MP + b * DECS) * D + h * HD;
    LAS float* Fs = (LAS float*)(F.lds + RING_OFF); LAS float* Wm = Fs + 1088; LAS float* Wl = Wm + 128; LAS float* Wo = (LAS float*)(F.lds + RING_OFF + 8192);
    if (F.wave == 0) {
        float v[17]; float run = 0.f;
#pragma unroll
        for (int e = 0; e < 17; ++e) { const int idx = F.lane * 17 + e; float x = 0.f; if (idx < PAST) x = clf[(size_t)idx * NH]; else if (idx < PAST + DECS) x = lfn[(size_t)(idx - PAST) * NH]; v[e] = x; run += x; }
        float acc = wave_incl_scan(run, F.lane) - run;
#pragma unroll
        for (int e = 0; e < 17; ++e) { const int idx = F.lane * 17 + e; acc += v[e]; if (idx < PAST + DECS) Fs[idx] = acc * LOG2E; }
    }
    __syncthreads();
    bf16x8 qf[2];
#pragma unroll
    for (int s = 0; s < 2; ++s) qf[s] = *(const bf16x8*)(qo + (size_t)n16 * D + 32 * s + 8 * quad);
    const float gq = Fs[PAST + n16];
    float m_run = -INFINITY, l_run = 0.f; f32x4 oacc[4];
#pragma unroll
    for (int d = 0; d < 4; ++d) oacc[d] = (f32x4){0.f, 0.f, 0.f, 0.f};
    for (int T = F.wave; T < 65; T += NWAVES) {
        const float* kb = (T < 64) ? ck + (size_t)(16 * T) * D : kn; const float* vb = (T < 64) ? cv + (size_t)(16 * T) * D : vn;
        const float* kr = kb + (size_t)n16 * D + 8 * quad;
        const f32x4 k0a = __builtin_nontemporal_load((const f32x4*)(kr)), k0b = __builtin_nontemporal_load((const f32x4*)(kr + 4)), k1a = __builtin_nontemporal_load((const f32x4*)(kr + 32)), k1b = __builtin_nontemporal_load((const f32x4*)(kr + 36));
        float vv[4][4];
#pragma unroll
        for (int d = 0; d < 4; ++d)
#pragma unroll
            for (int e = 0; e < 4; ++e) vv[d][e] = __builtin_nontemporal_load(vb + (size_t)(4 * quad + e) * D + 16 * d + n16);
        v4u kw0, kw1; kw0.x = pk2(k0a[0], k0a[1]); kw0.y = pk2(k0a[2], k0a[3]); kw0.z = pk2(k0b[0], k0b[1]); kw0.w = pk2(k0b[2], k0b[3]);
        kw1.x = pk2(k1a[0], k1a[1]); kw1.y = pk2(k1a[2], k1a[3]); kw1.z = pk2(k1b[0], k1b[1]); kw1.w = pk2(k1b[2], k1b[3]);
        f32x4 sc = __builtin_amdgcn_mfma_f32_16x16x32_bf16(__builtin_bit_cast(bf16x8, kw0), qf[0], (f32x4){0.f, 0.f, 0.f, 0.f}, 0, 0, 0);
        sc = __builtin_amdgcn_mfma_f32_16x16x32_bf16(__builtin_bit_cast(bf16x8, kw1), qf[1], sc, 0, 0, 0);
        const f32x4 gk = *(const LAS f32x4*)(Fs + 16 * T + 4 * quad);
#pragma unroll
        for (int e = 0; e < 4; ++e) { sc[e] += gq - gk[e]; if (T == 64 && (4 * quad + e) > n16) sc[e] = -INFINITY; }
        float mx = fmaxf(fmaxf(sc[0], sc[1]), fmaxf(sc[2], sc[3]));
        mx = xmax32(xmax16(mx));
        const float m_new = fmaxf(m_run, mx), scale = __builtin_amdgcn_exp2f(m_run - m_new);
        float p[4]; float ps = 0.f;
#pragma unroll
        for (int e = 0; e < 4; ++e) { p[e] = __builtin_amdgcn_exp2f(sc[e] - m_new); ps += p[e]; }
        l_run = l_run * scale + ps; m_run = m_new;
        v2u pw; pw.x = pk2(p[0], p[1]); pw.y = pk2(p[2], p[3]);
#pragma unroll
        for (int d = 0; d < 4; ++d) { v2u vw; vw.x = pk2(vv[d][0], vv[d][1]); vw.y = pk2(vv[d][2], vv[d][3]);
            oacc[d] = oacc[d] * scale;
            oacc[d] = __builtin_amdgcn_mfma_f32_16x16x16bf16_1k(__builtin_bit_cast(bf16x4, vw), __builtin_bit_cast(bf16x4, pw), oacc[d], 0, 0, 0); }
    }
    const float lt = xadd32(xadd16(l_run));
    if (quad == 0) { Wm[F.wave * 16 + n16] = m_run; Wl[F.wave * 16 + n16] = lt; }
#pragma unroll
    for (int d = 0; d < 4; ++d)
#pragma unroll
        for (int e = 0; e < 4; ++e) Wo[F.wave * 1024 + (16 * d + 4 * quad + e) * 16 + n16] = oacc[d][e];
    __syncthreads();
#pragma unroll
    for (int rep = 0; rep < 2; ++rep) {
        const int e = F.tid + rep * 512, q = e & 15, d = e >> 4;
        float ms = -INFINITY;
#pragma unroll
        for (int w = 0; w < NWAVES; ++w) ms = fmaxf(ms, Wm[w * 16 + q]);
        float num = 0.f, den = 0.f;
#pragma unroll
        for (int w = 0; w < NWAVES; ++w) { const float f = __builtin_amdgcn_exp2f(Wm[w * 16 + q] - ms); num += f * Wo[w * 1024 + e]; den += f * Wl[w * 16 + q]; }
        qo[(size_t)q * D + d] = (bf16)f2bf(num / den);
    }
    __syncthreads();
}
template <int W> __device__ __forceinline__ void pool_group(const Frame& F, const bf16* zsrc, int g, int R0, bool prompt, int t0, const float* hist, float mu_l, float rs_l, const float* gp, const float* bp, bf16* out) {
    const int c = 256 * g + 4 * F.lane;
    const f32x4 gg = *(const f32x4*)(gp + c), bb = *(const f32x4*)(bp + c);
    f32x4 xs[31];
#pragma unroll
    for (int L = 0; L < 31; ++L) {
        if (L < 15 - (W - 1)) continue;
        const int i = L - 15; const float m_ = __uint_as_float(__builtin_amdgcn_readlane(__float_as_uint(mu_l), L)), r_ = __uint_as_float(__builtin_amdgcn_readlane(__float_as_uint(rs_l), L));
        if (i >= 0 || (prompt && t0 + i >= 0)) { const v2u w = *(const GAS v2u*)(zsrc + (size_t)(R0 + i) * D + c); const f32x2g lo_ = upz<ZBF_O>(w.x), hi_ = upz<ZBF_O>(w.y); const f32x4 zv = {lo_.x, lo_.y, hi_.x, hi_.y};
            xs[L] = (zv - m_) * r_ * gg + bb; }
        else if (!prompt) xs[L] = *(const f32x4*)(hist + (size_t)(15 + i) * D + c);
        else xs[L] = (f32x4){0.f, 0.f, 0.f, 0.f};
    }
#pragma unroll
    for (int t = 0; t < 16; ++t) {
        f32x4 s = xs[15 + t];
#pragma unroll
        for (int k = 1; k < W; ++k) s += xs[15 + t - k];
        int cnt = W; if (prompt && t0 + t + 1 < W) cnt = t0 + t + 1;
        const f32x4 pv = s / (float)cnt - xs[15 + t];
        v2u w; w.x = pk2(pv[0], pv[1]); w.y = pk2(pv[2], pv[3]);
        *(GAS v2u*)(out + (size_t)(R0 + t) * D + c) = w;
    }
}
template <int DUMMY> __device__ __forceinline__ void pool_block(const Frame& F, const bf16* zsrc, const float* st, int g, int R0, bool prompt, const float* hist, const float* gp, const float* bp) {
    const int t0 = prompt ? (R0 & (SEQ - 1)) : 0;
    float mu_l = 0.f, rs_l = 1.f;
    { const int i = F.lane - 15; if (F.lane < 31 && (i >= 0 || (prompt && t0 + i >= 0))) row_stats_full(st, R0 + i, mu_l, rs_l); }
    if (g == 0) pool_group<2>(F, zsrc, 0, R0, prompt, t0, hist, mu_l, rs_l, gp, bp, F.R);
    else if (g == 1) pool_group<4>(F, zsrc, 1, R0, prompt, t0, hist, mu_l, rs_l, gp, bp, F.R);
    else if (g == 2) pool_group<8>(F, zsrc, 2, R0, prompt, t0, hist, mu_l, rs_l, gp, bp, F.R);
    else pool_group<16>(F, zsrc, 3, R0, prompt, t0, hist, mu_l, rs_l, gp, bp, F.R);
}
__device__ __forceinline__ void pool_own(const Frame& F, int jp, int kin) {
    const int gw = F.vcu * NWAVES + F.wave, NGW = F.G * NWAVES;
    const float* gp = ln_gk(F, kin); const float* bp = ln_bk(F, kin); const float* st = stk(F, kin); const bf16* zsrc = zbk(F, kin);
    for (int it = gw; it < NB * 15 + DECB * 15; it += NGW) {
        if (it < NB * 15) { const int b = it / 15, i = it % 15; ln_row_out(F, kin, b * SEQ + SEQ - 15 + i, F.out + O_PP + ((size_t)(jp * NB + b) * 15 + i) * D); }
        else { const int w = it - NB * 15, sb = w / 15, i = w % 15; ln_row_out(F, kin, MP + sb * DECS + 1 + i, F.out + O_PS + ((size_t)(jp * DECB + sb) * 15 + i) * D); }
    }
    pg8::StaticOrder S; S.init(MP, D, F.G, F.bx); pg8::Unit u;
    for (int ui = 0; S.next(ui, u); ++ui)
        for (int blk = F.wave; blk < 16; blk += NWAVES) pool_block<0>(F, zsrc, st, u.pn, u.pm * 256 + blk * 16, true, nullptr, gp, bp);
    for (int it = F.bx; it < 16 * (D / 64); it += F.G)
        if (F.wave < 2) { const int R0 = MP + (it & 15) * 32 + F.wave * 16; pool_block<0>(F, zsrc, st, (it >> 4) >> 2, R0, false, F.spool + ((size_t)jp * DECB + (R0 - MP) / DECS) * 15 * D, gp, bp); }
    __syncthreads();
}

enum { SE_SWIGLU = 0, SE_QKV = 1, SE_PP = 2, SE_RES0 = 3, SE_RES1 = 4, SE_RES2 = 5 };
struct SG { const bf16* A; int lda, agrp; const bf16* Bt; int K, ncb;
            const float* st; const float* gW; const float* bW;
            bf16* ob; float* ok;
            const bf16* zp; bf16* zb; float* st_out; const float* st_prev; const float* gp; const float* bp; float cs; const float* vec; const bf16* pp; };
__device__ __forceinline__ float red16(float v, int lane) { v += bperm(v, lane ^ 1); v += bperm(v, lane ^ 2); v += bperm(v, lane ^ 4); v += bperm(v, lane ^ 8); return v; }
#ifndef STAGGER
#define STAGGER 2
#endif
#ifndef PROBE_DUP
#define PROBE_DUP 0
#endif
template <int MODE, int NSTEPS, bool INBF, bool OUTBF> __device__ __forceinline__ void small_gemm(const Frame& F, const SG g, const int when) {
    if (STAGGER == 2 ? (when != 1) : !STAGGER ? (when != 0) : ((((F.bx >> 3) & 1) ^ when) == 0)) return;
    constexpr bool DUAL = (MODE == SE_SWIGLU), AF16 = (MODE == SE_SWIGLU) ? !ZBF_E : (MODE == SE_QKV || MODE == SE_RES2) ? !ZBF_O : false;
    constexpr int BS = DUAL ? 2 : 4, NB_ = (NSTEPS + BS - 1) / BS;
    const int n16 = F.lane & 15, quad = F.lane >> 4, ks = g.K >> 3, kbeg = F.wave * ks;
    LAS float* P = (LAS float*)(F.lds + RING_OFF);
    for (int rep_ = 0; rep_ < ((PROBE_DUP == 13) ? 2 : 1); ++rep_)
    for (int it = F.bx; it < 16 * g.ncb; it += F.G) {
        const int rb = it & 15, cb = it >> 4, row0 = MP + rb * 32;
        const int brow0 = DUAL ? 256 * (cb >> 1) + 64 * (cb & 1) : 64 * cb;
        const bf16* ap = g.A + (size_t)(row0 + n16) * g.lda + (g.agrp ? 256 * (cb >> 2) : 0) + kbeg + 8 * quad;
        const bf16* bp_ = g.Bt + (size_t)(brow0 + n16) * g.K + kbeg + 8 * quad;
        const int r = F.tid >> 4, c4 = (F.tid & 15) * 4, R = row0 + r, col = 64 * cb + c4; const size_t off = (size_t)R * D + col;
        f32x4 p4 = {0.f, 0.f, 0.f, 0.f}, va = {0.f, 0.f, 0.f, 0.f}, vb = {0.f, 0.f, 0.f, 0.f}, vc = {0.f, 0.f, 0.f, 0.f}, vd = {0.f, 0.f, 0.f, 0.f}; v2u zw = {0u, 0u}, pw = {0u, 0u};
        if (MODE != SE_PP) p4 = *(const f32x4*)(((MODE == SE_SWIGLU || MODE == SE_QKV) ? g.st : g.st_prev) + (size_t)R * 64 + 4 * (F.tid & 15));
        if (MODE == SE_SWIGLU) { const int arow = brow0 + c4; va = *(const f32x4*)(g.bW + arow); vb = *(const f32x4*)(g.gW + arow); vc = *(const f32x4*)(g.bW + arow + 128); vd = *(const f32x4*)(g.gW + arow + 128); }
        if (MODE == SE_QKV || MODE == SE_RES2) { va = *(const f32x4*)(g.bW + col); vb = *(const f32x4*)(g.gW + col); }
        if (MODE == SE_RES0 || MODE == SE_RES1 || MODE == SE_RES2) { zw = *(const GAS v2u*)(g.zp + off); vc = *(const f32x4*)(g.gp + col); vd = *(const f32x4*)(g.bp + col); }
        if (MODE == SE_RES1) va = *(const f32x4*)(g.vec + col);
        if (MODE == SE_RES2) pw = *(const GAS v2u*)(g.pp + off);
        f32x4 acc[2][4], accu[2][4];
#pragma unroll
        for (int mt = 0; mt < 2; ++mt)
#pragma unroll
            for (int nt = 0; nt < 4; ++nt) { acc[mt][nt] = (f32x4){0.f, 0.f, 0.f, 0.f}; accu[mt][nt] = (f32x4){0.f, 0.f, 0.f, 0.f}; }
        bf16x8 fa[2][BS][2], fb[2][BS][4], fu[2][BS][4];
#define SG_LOAD(buf, b0_) do { _Pragma("unroll") for (int s_ = 0; s_ < BS; ++s_) if ((b0_) * BS + s_ < NSTEPS) { const int ko = 32 * ((b0_) * BS + s_); \
            _Pragma("unroll") for (int mt = 0; mt < 2; ++mt) fa[buf][s_][mt] = *(const bf16x8*)(ap + (size_t)(16 * mt) * g.lda + ko); \
            _Pragma("unroll") for (int nt = 0; nt < 4; ++nt) { fb[buf][s_][nt] = *(const bf16x8*)(bp_ + (size_t)(16 * nt) * g.K + ko); if (DUAL) fu[buf][s_][nt] = *(const bf16x8*)(bp_ + (size_t)(128 + 16 * nt) * g.K + ko); } } } while (0)
        SG_LOAD(0, 0);
#pragma unroll
        for (int b = 0; b < NB_; ++b) {
            if (b + 1 < NB_) SG_LOAD((b + 1) & 1, b + 1);
#pragma unroll
            for (int s_ = 0; s_ < BS; ++s_) if (b * BS + s_ < NSTEPS) {
#pragma unroll
                for (int mt = 0; mt < 2; ++mt)
#pragma unroll
                    for (int nt = 0; nt < 4; ++nt) {
                        if (AF16) acc[mt][nt] = __builtin_amdgcn_mfma_f32_16x16x32_f16(__builtin_bit_cast(h16x8, fb[b & 1][s_][nt]), __builtin_bit_cast(h16x8, fa[b & 1][s_][mt]), acc[mt][nt], 0, 0, 0);
                        else acc[mt][nt] = __builtin_amdgcn_mfma_f32_16x16x32_bf16(fb[b & 1][s_][nt], fa[b & 1][s_][mt], acc[mt][nt], 0, 0, 0);
                        if (DUAL) accu[mt][nt] = AF16 ? __builtin_amdgcn_mfma_f32_16x16x32_f16(__builtin_bit_cast(h16x8, fu[b & 1][s_][nt]), __builtin_bit_cast(h16x8, fa[b & 1][s_][mt]), accu[mt][nt], 0, 0, 0) : __builtin_amdgcn_mfma_f32_16x16x32_bf16(fu[b & 1][s_][nt], fa[b & 1][s_][mt], accu[mt][nt], 0, 0, 0);
                    }
            }
        }
#undef SG_LOAD
#pragma unroll
        for (int mt = 0; mt < 2; ++mt)
#pragma unroll
            for (int nt = 0; nt < 4; ++nt) { const int o = F.wave * 2048 + (16 * mt + n16) * 64 + (((4 * nt + quad) ^ n16) << 2); *(LAS f32x4*)(P + o) = acc[mt][nt]; if (DUAL) *(LAS f32x4*)(P + 16384 + o) = accu[mt][nt]; }
        asm volatile("s_waitcnt lgkmcnt(0)\n\ts_barrier" ::: "memory");
        f32x4 v = {0.f, 0.f, 0.f, 0.f}, vu = {0.f, 0.f, 0.f, 0.f};
        { const int o = r * 64 + ((((F.tid & 15)) ^ (r & 15)) << 2);
#pragma unroll
          for (int w = 0; w < NWAVES; ++w) { v += *(const LAS f32x4*)(P + w * 2048 + o); if (DUAL) vu += *(const LAS f32x4*)(P + 16384 + w * 2048 + o); } }
        float mu = 0.f, rs = 1.f;
        if (MODE != SE_PP) {
            const float s_ = red16(p4[0] + p4[2], F.lane), q_ = red16(p4[1] + p4[3], F.lane);
            mu = s_ * (1.0f / 1024.0f); rs = 1.0f / sqrtf(fmaxf(q_ * (1.0f / 1024.0f) - mu * mu, 0.f) + LN_EPS);
        }
        const float mr = mu * rs;
        if (MODE == SE_SWIGLU) {
            f32x4 a_ = v * rs + (va - mr * vb);
            const f32x4 u_ = vu * rs + (vc - mr * vd);
#pragma unroll
            for (int e = 0; e < 4; ++e) a_[e] = a_[e] * __builtin_amdgcn_rcpf(1.0f + __builtin_amdgcn_exp2f(-LOG2E * a_[e])) * u_[e];
            v2u w; w.x = pg8::cvt_pk_bf16(a_[0], a_[1]); w.y = pg8::cvt_pk_bf16(a_[2], a_[3]);
            *(GAS v2u*)(g.ob + (size_t)R * DFF + col) = w;
        } else if (MODE == SE_QKV) {
            const int t = col >> 10, cc = col & 1023;
            const f32x4 y = v * rs + (va - mr * vb);
            const float sc = (t == 0) ? C2 : 1.0f;
            v2u w; w.x = pg8::cvt_pk_bf16(y[0] * sc, y[1] * sc); w.y = pg8::cvt_pk_bf16(y[2] * sc, y[3] * sc);
            *(GAS v2u*)(g.ob + (size_t)t * ((size_t)M * D) + (size_t)R * D + cc) = w;
            if (t != 0) *(GAS f32x4*)(g.ok + (t == 2 ? 2ull * MS * D : 0ull) + (size_t)(R - MP) * D + cc) = y;
        } else if (MODE == SE_PP) {
            v2u w; w.x = pg8::cvt_pk_bf16(v[0], v[1]); w.y = pg8::cvt_pk_bf16(v[2], v[3]);
            *(GAS v2u*)(g.ob + off) = w;
        } else {
            const f32x2g zl_ = upz<INBF>(zw.x), zh_ = upz<INBF>(zw.y); const f32x4 zi = {zl_.x, zl_.y, zh_.x, zh_.y};
            const f32x4 xa = ((zi * rs - mr) * vc + vd) * ALPHA;
            f32x4 zn;
            if (MODE == SE_RES0) zn = xa + v * g.cs;
            else if (MODE == SE_RES1) zn = xa + v * va;
            else {
                f32x4 y = v * rs + (va - mr * vb);
#pragma unroll
                for (int e = 0; e < 4; ++e) y[e] = __builtin_amdgcn_rcpf(1.0f + __builtin_amdgcn_exp2f(-LOG2E * y[e]));
                f32x4 pf; pf[0] = __uint_as_float(pw.x << 16); pf[1] = __uint_as_float(pw.x & 0xffff0000u); pf[2] = __uint_as_float(pw.y << 16); pf[3] = __uint_as_float(pw.y & 0xffff0000u);
                zn = xa + pf * y;
            }
            v2u w; w.x = pkz<OUTBF>(zn[0], zn[1]); w.y = pkz<OUTBF>(zn[2], zn[3]);
            *(GAS v2u*)(g.zb + off) = w;
            { const f32x2g a_ = upz<OUTBF>(w.x), b_ = upz<OUTBF>(w.y); zn = (f32x4){a_.x, a_.y, b_.x, b_.y}; }
            const float s_ = red16((zn[0] + zn[1]) + (zn[2] + zn[3]), F.lane), q_ = red16((zn[0] * zn[0] + zn[1] * zn[1]) + (zn[2] * zn[2] + zn[3] * zn[3]), F.lane);
            if ((F.tid & 15) == 0) *(GAS f32x4*)(g.st_out + (size_t)R * 64 + 4 * cb) = (f32x4){s_, q_, 0.f, 0.f};
        }
        asm volatile("s_waitcnt lgkmcnt(0)\n\ts_barrier" ::: "memory");
    }
}

#ifndef PEEL_FIN
#define PEEL_FIN 1
#define PEEL_FOUT 1
#define PEEL_QKV 1
#define PEEL_OPROJ 1
#define PEEL_POOL 1
#define PEEL_PLEA 1
#define PEEL_PLEB 0
#endif
#define RING(F) ((PG8_LAS unsigned char*)((F).lds + RING_OFF))
__device__ __forceinline__ void ph_ffn_in(const Frame& F, int i, int s, int dry = 0) {
    const int f = i * 2 + s, kin = 4 * i + 2 * s;
    pg8::Gemm g{zbk(F, kin), (const bf16*)(F.ws + WS_WFIN) + (size_t)f * 2 * DFF * D, MP, 2 * DFF, D, D, 0}; pg8::StaticOrder S; S.init(MP, 2 * DFF, F.G, F.bx);
    pg8::EpiSwiglu E{F.R, (pg8::StatTab)(F.lds + STAT_OFF), F.vec + V_FIN + f * 11264, F.vec + V_FIN + f * 11264 + 5632, dry, (PG8_LAS float*)(F.lds + EVEC_OFF)};
    pg8::gemm_phase<pg8::EpiSwiglu, pg8::StaticOrder, true, true, !ZBF_E, PEEL_FIN, StatsHook<pg8::StaticOrder>>(RING(F), g, S, E, F.tid, StatsHook<pg8::StaticOrder>{F, S, stk(F, kin)});
}
__device__ __forceinline__ void ph_ffn_out(const Frame& F, int i, int s, int dry = 0) {
    const int f = i * 2 + s, kin = 4 * i + 2 * s, kout = kin + 1;
    pg8::Gemm g{F.R, (const bf16*)(F.ws + WS_WFOUT) + (size_t)f * D * DFF, MP, D, DFF, DFF, 0}; pg8::StaticOrder S; S.init(MP, D, F.G, F.bx);
    pg8::EpiRes<0, ZBF_E, ZBF_O> E{zbk(F, kin), zbk(F, kout), stk(F, kout), (pg8::StatTab)(F.lds + STAT_OFF), ln_gk(F, kin), ln_bk(F, kin), 0.5f, nullptr, nullptr, nullptr, nullptr, dry};
    stats_to_lds(F, S, stk(F, kin));
    pg8::gemm_phase<pg8::EpiRes<0, ZBF_E, ZBF_O>, pg8::StaticOrder, true, true, false, PEEL_FOUT>(RING(F), g, S, E, F.tid);
}
__device__ __forceinline__ void ph_qkv(const Frame& F, int i) {
    const int j = i >> 1, kin = 4 * i + 1;
    pg8::Gemm g{zbk(F, kin), (const bf16*)(F.ws + WS_WQKV) + (size_t)j * 3072 * D, MP, 3072, D, D, 0}; pg8::StaticOrder S; S.init(MP, 3072, F.G, F.bx);
    static_assert(O_VP - O_KP == 2ull * MP * D && O_VS - O_KS == 2ull * MS * D, "EpiQKV output arithmetic");
    pg8::EpiQKV E{F.R, F.out + O_KP + (size_t)j * MP * D, F.out + O_KS + (size_t)j * MS * D, (pg8::StatTab)(F.lds + STAT_OFF), F.vec + V_QKV + j * 6144, F.vec + V_QKV + j * 6144 + 3072};
    pg8::gemm_phase<pg8::EpiQKV, pg8::StaticOrder, true, true, !ZBF_O, PEEL_QKV, StatsHook<pg8::StaticOrder>>(RING(F), g, S, E, F.tid, StatsHook<pg8::StaticOrder>{F, S, stk(F, kin)});
}
__device__ __forceinline__ void ph_oproj(const Frame& F, int i) {
    const int j = i >> 1, kin = 4 * i + 1, kout = kin + 1;
    pg8::Gemm g{F.R, (const bf16*)(F.ws + WS_WWO) + (size_t)j * D * D, MP, D, D, D, 0}; pg8::StaticOrder S; S.init(MP, D, F.G, F.bx);
    pg8::EpiRes<0, ZBF_O, ZBF_E> E{zbk(F, kin), zbk(F, kout), stk(F, kout), (pg8::StatTab)(F.lds + STAT_OFF), ln_gk(F, kin), ln_bk(F, kin), 1.0f, nullptr, nullptr, nullptr, nullptr, 0};
    stats_to_lds(F, S, stk(F, kin));
    pg8::gemm_phase<pg8::EpiRes<0, ZBF_O, ZBF_E>, pg8::StaticOrder, true, true, false, PEEL_OPROJ>(RING(F), g, S, E, F.tid);
}
__device__ __forceinline__ void ph_poolgemm(const Frame& F, int i) {
    const int jp = i >> 1, kin = 4 * i + 1, kout = kin + 1;
    pg8::Gemm g{F.R, (const bf16*)(F.ws + WS_WPOOL) + (size_t)jp * D * 256, MP, D, 256, D, 512}; pg8::StaticOrder S; S.init(MP, D, F.G, F.bx);
    pg8::EpiRes<1, ZBF_O, ZBF_E> E{zbk(F, kin), zbk(F, kout), stk(F, kout), (pg8::StatTab)(F.lds + STAT_OFF), ln_gk(F, kin), ln_bk(F, kin), 1.0f, F.pool_scale + (size_t)jp * D, nullptr, nullptr, nullptr, 0};
    stats_to_lds(F, S, stk(F, kin));
    pg8::gemm_phase<pg8::EpiRes<1, ZBF_O, ZBF_E>, pg8::StaticOrder, true, true, false, PEEL_POOL>(RING(F), g, S, E, F.tid);
}
__device__ __forceinline__ void ph_ple_a(const Frame& F, int i) {
    { pg8::Gemm g{F.PB + (size_t)i * M * PLE, (const bf16*)(F.ws + WS_WPROJ) + (size_t)i * D * PLE, MP, D, PLE, PLE, 0}; pg8::StaticOrder S; S.init(MP, D, F.G, F.bx);
      pg8::EpiStoreBf16 E{F.R};
      pg8::gemm_phase<pg8::EpiStoreBf16, pg8::StaticOrder, true, true, false, PEEL_PLEA>(RING(F), g, S, E, F.tid); }
}
__device__ __forceinline__ void ph_ple_b(const Frame& F, int i) {
    const int kin = 4 * i + 3, kout = kin + 1;
    { pg8::Gemm g{zbk(F, kin), (const bf16*)(F.ws + WS_WGW) + (size_t)i * D * D, MP, D, D, D, 0}; pg8::StaticOrder S; S.init(MP, D, F.G, F.bx);
      pg8::EpiRes<2, ZBF_O, ZBF_E> E{zbk(F, kin), zbk(F, kout), stk(F, kout), (pg8::StatTab)(F.lds + STAT_OFF), ln_gk(F, kin), ln_bk(F, kin), 1.0f, nullptr, F.vec + V_GW + i * 2048, F.vec + V_GW + i * 2048 + 1024, F.R, 0};
      stats_to_lds(F, S, stk(F, kin));
      pg8::gemm_phase<pg8::EpiRes<2, ZBF_O, ZBF_E>, pg8::StaticOrder, true, true, !ZBF_O, PEEL_PLEB>(RING(F), g, S, E, F.tid); }
}

__device__ __forceinline__ void ps_ffn_in(const Frame& F, int i, int s, int when) {
    const int f = i * 2 + s, kin = 4 * i + 2 * s;
    SG g{}; g.A = zbk(F, kin); g.lda = D; g.Bt = (const bf16*)(F.ws + WS_WFIN) + (size_t)f * 2 * DFF * D; g.K = D; g.ncb = DFF / 64;
    g.st = stk(F, kin); g.gW = F.vec + V_FIN + f * 11264; g.bW = F.vec + V_FIN + f * 11264 + 5632; g.ob = F.R;
    small_gemm<SE_SWIGLU, 4, false, false>(F, g, when);
}
__device__ __forceinline__ void ps_ffn_out(const Frame& F, int i, int s, int when) {
    const int f = i * 2 + s, kin = 4 * i + 2 * s, kout = kin + 1;
    SG g{}; g.A = F.R; g.lda = DFF; g.Bt = (const bf16*)(F.ws + WS_WFOUT) + (size_t)f * D * DFF; g.K = DFF; g.ncb = D / 64;
    g.zp = zbk(F, kin); g.zb = zbk(F, kout); g.st_out = stk(F, kout); g.st_prev = stk(F, kin); g.gp = ln_gk(F, kin); g.bp = ln_bk(F, kin); g.cs = 0.5f;
    small_gemm<SE_RES0, 11, ZBF_E, ZBF_O>(F, g, when);
}
__device__ __forceinline__ void ps_qkv(const Frame& F, int i, int when) {
    const int j = i >> 1, kin = 4 * i + 1;
    SG g{}; g.A = zbk(F, kin); g.lda = D; g.Bt = (const bf16*)(F.ws + WS_WQKV) + (size_t)j * 3072 * D; g.K = D; g.ncb = 3072 / 64;
    g.st = stk(F, kin); g.gW = F.vec + V_QKV + j * 6144; g.bW = F.vec + V_QKV + j * 6144 + 3072; g.ob = F.R; g.ok = F.out + O_KS + (size_t)j * MS * D;
    small_gemm<SE_QKV, 4, false, false>(F, g, when);
}
__device__ __forceinline__ void ps_oproj(const Frame& F, int i, int when) {
    const int j = i >> 1, kin = 4 * i + 1, kout = kin + 1;
    SG g{}; g.A = F.R; g.lda = D; g.Bt = (const bf16*)(F.ws + WS_WWO) + (size_t)j * D * D; g.K = D; g.ncb = D / 64;
    g.zp = zbk(F, kin); g.zb = zbk(F, kout); g.st_out = stk(F, kout); g.st_prev = stk(F, kin); g.gp = ln_gk(F, kin); g.bp = ln_bk(F, kin); g.cs = 1.0f;
    small_gemm<SE_RES0, 4, ZBF_O, ZBF_E>(F, g, when);
}
__device__ __forceinline__ void ps_poolgemm(const Frame& F, int i, int when) {
    const int jp = i >> 1, kin = 4 * i + 1, kout = kin + 1;
    SG g{}; g.A = F.R; g.lda = D; g.agrp = 1; g.Bt = (const bf16*)(F.ws + WS_WPOOL) + (size_t)jp * D * 256; g.K = 256; g.ncb = D / 64;
    g.zp = zbk(F, kin); g.zb = zbk(F, kout); g.st_out = stk(F, kout); g.st_prev = stk(F, kin); g.gp = ln_gk(F, kin); g.bp = ln_bk(F, kin); g.vec = F.pool_scale + (size_t)jp * D;
    small_gemm<SE_RES1, 1, ZBF_O, ZBF_E>(F, g, when);
}
__device__ __forceinline__ void ps_ple_a(const Frame& F, int i, int when) {
    SG g{}; g.A = F.PB + (size_t)i * M * PLE; g.lda = PLE; g.Bt = (const bf16*)(F.ws + WS_WPROJ) + (size_t)i * D * PLE; g.K = PLE; g.ncb = D / 64; g.ob = F.R;
    small_gemm<SE_PP, 1, false, false>(F, g, when);
}
__device__ __forceinline__ void ps_ple_b(const Frame& F, int i, int when) {
    const int kin = 4 * i + 3, kout = kin + 1;
    SG g{}; g.A = zbk(F, kin); g.lda = D; g.Bt = (const bf16*)(F.ws + WS_WGW) + (size_t)i * D * D; g.K = D; g.ncb = D / 64;
    g.gW = F.vec + V_GW + i * 2048; g.bW = F.vec + V_GW + i * 2048 + 1024; g.pp = F.R;
    g.zp = zbk(F, kin); g.zb = zbk(F, kout); g.st_out = stk(F, kout); g.st_prev = stk(F, kin); g.gp = ln_gk(F, kin); g.bp = ln_bk(F, kin);
    small_gemm<SE_RES2, 4, ZBF_O, ZBF_E>(F, g, when);
}

__global__ void __launch_bounds__(NWAVES * 64, 2) fwd_kernel(Args args) {
    extern __shared__ __attribute__((aligned(16))) unsigned char lds[];
    Base B;
    B.lds = (LAS unsigned char*)lds;
    volatile LAS unsigned* MISC = (volatile LAS unsigned*)(B.lds + MISC_OFF);
    B.wave = __builtin_amdgcn_readfirstlane((int)threadIdx.x >> 6);
    B.G = gridDim.x;
    for (int u = threadIdx.x; u < (STAT_OFF - LDSCTL_OFF) / 4; u += NWAVES * 64) ((LAS unsigned*)(B.lds + LDSCTL_OFF))[u] = 0u;
    __syncthreads();
    XcdBarrier bar; bar.bar = (unsigned*)(args.ws + WS_CTL) + CW_BAR; bar.x = 0; bar.st = nullptr;
    if (!MK_PER_PHASE) bar = xcd_barrier_post((unsigned*)(args.ws + WS_CTL) + CW_BAR, MISC + 8);
    const int lo = args.ph_lo, hi = args.ph_hi;
#define IN(k) (lo <= (k) && (k) < hi)
#define RUN(kind) for (int r_ = 0; r_ < ((PROBE_DUP == (kind)) ? 2 : 1); ++r_)
#define SEAM() do { if (!MK_PER_PHASE) xcd_barrier(bar); } while (0)

    if (IN(0)) { RUN(8) { Frame F = mkframe(B); p0_prologue(F); } SEAM(); }
    for (int i = 0; i < DEPTH; ++i) {
        const int pb = 1 + 10 * i;
        if (IN(pb + 0)) { if (PROBE_DUP == 11) { const Frame F = mkframe(B); ph_ffn_in(F, i, 0, F.G > 0); } RUN(1) { { const Frame F = mkframe(B); ps_ffn_in(F, i, 0, 0); } { const Frame F = mkframe(B); ph_ffn_in(F, i, 0); } { const Frame F = mkframe(B); ps_ffn_in(F, i, 0, 1); } } SEAM(); }
        if (IN(pb + 1)) { if (PROBE_DUP == 12) { const Frame F = mkframe(B); ph_ffn_out(F, i, 0, F.G > 0); } RUN(2) { { const Frame F = mkframe(B); ps_ffn_out(F, i, 0, 0); } { const Frame F = mkframe(B); ph_ffn_out(F, i, 0); } { const Frame F = mkframe(B); ps_ffn_out(F, i, 0, 1); } } SEAM(); }
        if ((i & 1) == 0) {
            const int j = i >> 1, kin = 4 * i + 1;
            if (IN(pb + 2)) { RUN(3) { { const Frame F = mkframe(B); ps_qkv(F, i, 0); } { const Frame F = mkframe(B); ph_qkv(F, i); } { const Frame F = mkframe(B); ps_qkv(F, i, 1); } { const Frame F = mkframe(B); gate_proj(F, j, kin); } } SEAM(); }
            if (IN(pb + 3)) { RUN(9) { const Frame F = mkframe(B); fox_scan(F, j); } SEAM(); }
            if (IN(pb + 4)) {
                volatile LAS unsigned* tk = MISC + 16;
                volatile LAS int* T0l = (volatile LAS int*)(B.lds + STAT_OFF);
                { const Frame F = mkframe(B); const GAS int* tg = (const GAS int*)(F.ws + WS_T0) + j * 2048; for (int e = F.tid; e < 2048; e += NWAVES * 64) T0l[e] = tg[e]; }
                __syncthreads();
                for (int pass_ = ((PROBE_DUP == 14) ? 0 : 1); pass_ < 2; ++pass_) {
                bool have = false; int slot = 0;
                for (;;) {
                    const Frame F = mkframe(B);
                    gu32* qctr = (gu32*)(F.ws + WS_CTL) + CW_QUEUE + 64 * (j + 2 * (1 - pass_));
                    if (!have) { if (F.tid == 0) tk[slot] = __hip_atomic_fetch_add(qctr, 1u, RLX_AGENT); __syncthreads(); }
                    const int n = (int)tk[slot];
                    if (n >= NB * NH * 32 + DECB * NH) break;
                    const int grp = n / 5, rem = n - 5 * grp;
                    if (rem < 4) {
                        const int pu = 4 * grp + rem;
                        const int hh = 15 - (pu >> 7), r = pu & 127, qb = 31 - (r >> 2), b = r & 3, bh = b * NH + hh;
                        const float* Gbh = F.GT + (size_t)bh * SEQ;
                        const attn_body::bf16* Qb = (const attn_body::bf16*)F.R; const attn_body::bf16* Kb = Qb + (size_t)M * D; const attn_body::bf16* Vb = Kb + (size_t)M * D;
                        attn_body::attn_unit<16>(b, hh, qb, Qb, Kb, Vb, pass_ ? (attn_body::bf16*)F.R : (attn_body::bf16*)zbk(F, kin + 1), Gbh, (char*)lds + RING_OFF, F.tid, __builtin_amdgcn_readfirstlane(T0l[bh * 32 + qb]), (unsigned*)qctr, tk + (slot ^ 1));
                        have = true;
                    } else { if (pass_) sample_attn_item(F, j, grp >> 4, grp & 15); have = false; }
                    slot ^= 1;
                }
                }
                SEAM();
            }
            if (IN(pb + 5)) { RUN(4) { { const Frame F = mkframe(B); ps_oproj(F, i, 0); } { const Frame F = mkframe(B); ph_oproj(F, i); } { const Frame F = mkframe(B); ps_oproj(F, i, 1); } } SEAM(); }
        } else {
            if (IN(pb + 3)) { RUN(6) { { const Frame F = mkframe(B); pool_own(F, i >> 1, 4 * i + 1); } { const Frame F = mkframe(B); ps_poolgemm(F, i, 0); } { const Frame F = mkframe(B); ph_poolgemm(F, i); } { const Frame F = mkframe(B); ps_poolgemm(F, i, 1); } } SEAM(); }
        }
        if (IN(pb + 6)) { if (PROBE_DUP == 11) { const Frame F = mkframe(B); ph_ffn_in(F, i, 1, F.G > 0); } RUN(1) { { const Frame F = mkframe(B); ps_ffn_in(F, i, 1, 0); } { const Frame F = mkframe(B); ph_ffn_in(F, i, 1); } { const Frame F = mkframe(B); ps_ffn_in(F, i, 1, 1); } } SEAM(); }
        if (IN(pb + 7)) { if (PROBE_DUP == 12) { const Frame F = mkframe(B); ph_ffn_out(F, i, 1, F.G > 0); } RUN(2) { { const Frame F = mkframe(B); ps_ffn_out(F, i, 1, 0); } { const Frame F = mkframe(B); ph_ffn_out(F, i, 1); } { const Frame F = mkframe(B); ps_ffn_out(F, i, 1, 1); } } SEAM(); }
        if (IN(pb + 8)) { RUN(7) { { const Frame F = mkframe(B); ps_ple_a(F, i, 0); } { const Frame F = mkframe(B); ps_ple_b(F, i, 0); } { const Frame F = mkframe(B); ph_ple_a(F, i); } { const Frame F = mkframe(B); ph_ple_b(F, i); } { const Frame F = mkframe(B); ps_ple_a(F, i, 1); } { const Frame F = mkframe(B); ps_ple_b(F, i, 1); } } SEAM(); }
    }
    if (IN(41)) RUN(10) {
        const Frame F = mkframe(B);
        const int gw = F.vcu * NWAVES + F.wave, NGW = F.G * NWAVES;
        for (int m = gw; m < M; m += 2 * NGW) {
            const int m2 = m + NGW; const bool two = m2 < M;
            float mu1, rs1, mu2 = 0.f, rs2 = 1.f; row_stats_full(stk(F, 16), m, mu1, rs1); if (two) row_stats_full(stk(F, 16), m2, mu2, rs2);
            const GAS v2u* z1 = (const GAS v2u*)(zbk(F, 16) + (size_t)m * D) + F.lane; const GAS v2u* z2 = (const GAS v2u*)(zbk(F, 16) + (size_t)(two ? m2 : m) * D) + F.lane;
            const GAS f32x4* gi = (const GAS f32x4*)ln_gk(F, 16) + F.lane; const GAS f32x4* bi = (const GAS f32x4*)ln_bk(F, 16) + F.lane;
            v2u w1[4], w2[4];
#pragma unroll
            for (int j = 0; j < 4; ++j) { w1[j] = z1[64 * j]; w2[j] = z2[64 * j]; }
#pragma unroll
            for (int j = 0; j < 4; ++j) { const f32x4 g_ = gi[64 * j], b_ = bi[64 * j];
                const f32x2g l1 = upz<ZBF_E>(w1[j].x), h1 = upz<ZBF_E>(w1[j].y), l2 = upz<ZBF_E>(w2[j].x), h2 = upz<ZBF_E>(w2[j].y); const f32x4 a1 = {l1.x, l1.y, h1.x, h1.y}, a2 = {l2.x, l2.y, h2.x, h2.y};
                __builtin_nontemporal_store((a1 - mu1) * rs1 * g_ + b_, (f32x4*)((GAS f32x4*)(F.out + (size_t)m * D) + F.lane + 64 * j));
                if (two) __builtin_nontemporal_store((a2 - mu2) * rs2 * g_ + b_, (f32x4*)((GAS f32x4*)(F.out + (size_t)m2 * D) + F.lane + 64 * j)); }
        }
    }
#undef IN
#undef SEAM
#undef RUN
}

extern "C" void kernel_launch(void* const* d_in, const int* in_sizes, int n_in, void* d_out, int out_size, void* d_ws, size_t ws_size, hipStream_t stream) {
    static int grid = 0;
    if (grid == 0) {
        if (n_in != 20 || in_sizes[0] != MP * D || (size_t)out_size != O_END || ws_size < WS_END) {
            fprintf(stderr, "kernel_launch: unexpected shapes: n_in %d in0 %d out %d ws %zu (need %zu); nothing launched\n", n_in, n_in > 0 ? in_sizes[0] : -1, out_size, ws_size, (size_t)WS_END); grid = -1; return; }
        int dev = 0, cus = 0, per_cu = 0;
        if (hipGetDevice(&dev) != hipSuccess || hipDeviceGetAttribute(&cus, hipDeviceAttributeMultiprocessorCount, dev) != hipSuccess) { grid = -1; return; }
        if (hipFuncSetAttribute((const void*)fwd_kernel, hipFuncAttributeMaxDynamicSharedMemorySize, LDS_BYTES) != hipSuccess) { fprintf(stderr, "kernel_launch: hipFuncSetAttribute failed\n"); grid = -1; return; }
        if (hipOccupancyMaxActiveBlocksPerMultiprocessor(&per_cu, (const void*)fwd_kernel, NWAVES * 64, LDS_BYTES) != hipSuccess || per_cu < 1) { fprintf(stderr, "kernel_launch: occupancy query reports %d blocks per CU\n", per_cu); }
        (void)hipGetLastError();
        grid = cus;
        if (grid != 256) fprintf(stderr, "kernel_launch: %d CUs (expected 256)\n", grid);
    }
    if (grid < 0) return;
    (void)hipMemsetAsync((char*)d_ws + WS_CTL, 0, CTL_ZERO_BYTES, stream);
    Args a{};
    for (int i = 0; i < 20; ++i) a.in[i] = (const float*)d_in[i];
    a.out = (float*)d_out; a.ws = (unsigned char*)d_ws;
#if MK_PER_PHASE
    for (int p = 0; p < 42; ++p) { a.ph_lo = p; a.ph_hi = p + 1; hipLaunchKernelGGL(fwd_kernel, dim3(grid), dim3(NWAVES * 64), LDS_BYTES, stream, a); }
#else
    a.ph_lo = 0; a.ph_hi = 42;
    hipLaunchKernelGGL(fwd_kernel, dim3(grid), dim3(NWAVES * 64), LDS_BYTES, stream, a);
#endif
    const hipError_t le = hipPeekAtLastError();
    if (le != hipSuccess) fprintf(stderr, "kernel_launch: launch failed: %s\n", hipGetErrorName(le));
}
```
